# Optimizing an MI355X kernel written in HIP

```python
import math
import jax, jax.numpy as jnp
from jax import lax
import numpy as np

D_MODEL = 2048
BATCH = 2
SEQ = 4096
DEPTH = 2

HEAD_DIM = 64
A_Q_HEADS = 16
A_KV_HEADS = 2
A_GROUP = A_Q_HEADS // A_KV_HEADS
A_WINDOW = 128
A_BLOCK = 128
T5_BUCKETS = 32
T5_MAX_DIST = 128
B_HEADS = 16
GRID_W = 64
NA_WIN_H = 8
NA_WIN_W = 16
A_WIDTH = A_Q_HEADS * HEAD_DIM
A_KV_WIDTH = A_KV_HEADS * HEAD_DIM
B_WIDTH = B_HEADS * HEAD_DIM
ATTN_IN = A_WIDTH + 2 * A_KV_WIDTH + 3 * B_WIDTH
MIX_WIDTH = A_WIDTH + B_WIDTH
HYENA_ORDER = 2
HYENA_WIDTH = D_MODEL
HYENA_EMB = 33
HYENA_FILTER_HIDDEN = 64
HYENA_SHORT = 3
HYENA_DECAY_TARGET = 1e-2
HYENA_FAST_PCT = 0.3
HYENA_SLOW_PCT = 1.5
D_FF = 5632
N_EXPERTS = 8
TOP_K = 2
D_FF_EXPERT = 7168
MOE_BLOCK = 128
PLE_DIM = 256
RMS_EPS = 1e-6

kernel_name = 'hybrid_swa_natten_hyena_moe_encoder'

F32 = jnp.float32
NEG_INF = -1e30


def rmsnorm(x, g):
    xf = x.astype(F32)
    y = xf * lax.rsqrt(jnp.mean(xf * xf, axis=-1, keepdims=True) + RMS_EPS)
    return (y * g.astype(F32)).astype(x.dtype)


def t5_bucket(rel):
    half = T5_BUCKETS // 2
    max_exact = half // 2
    n = jnp.abs(rel)
    log_ratio = jnp.log(jnp.maximum(n, 1).astype(F32) / max_exact) / math.log(T5_MAX_DIST / max_exact)
    large = jnp.minimum(max_exact + (log_ratio * (half - max_exact)).astype(jnp.int32), half - 1)
    return jnp.where(rel > 0, half, 0) + jnp.where(n < max_exact, n, large)


def window_gqa(q, k, v, t5_bias, sink):
    B, S = q.shape[0], q.shape[1]
    nb = S // A_BLOCK
    qb = q.reshape(B, nb, A_BLOCK, A_KV_HEADS, A_GROUP, HEAD_DIM)
    pad = ((0, 0), (A_WINDOW, A_WINDOW), (0, 0), (0, 0))

    def band(t):
        tp = jnp.pad(t, pad).reshape(B, nb + 2, A_BLOCK, A_KV_HEADS, HEAD_DIM)
        return jnp.concatenate([tp[:, :-2], tp[:, 1:-1], tp[:, 2:]], axis=2)

    kb, vb = band(k), band(v)
    s = jnp.einsum('bnikgd,bnjkd->bnkgij', qb, kb).astype(F32) * (HEAD_DIM ** -0.5)
    i = jnp.arange(A_BLOCK)[:, None]
    j = jnp.arange(3 * A_BLOCK)[None, :]
    rel = j - A_WINDOW - i
    bias = t5_bias.astype(F32)[t5_bucket(rel)]
    bias = bias.transpose(2, 0, 1).reshape(A_KV_HEADS, A_GROUP, A_BLOCK, 3 * A_BLOCK)
    kpos = jnp.arange(nb)[:, None, None] * A_BLOCK - A_WINDOW + j[None]
    ok = (jnp.abs(rel) <= A_WINDOW)[None] & (kpos >= 0) & (kpos < S)
    s = jnp.where(ok[None, :, None, None], s + bias, NEG_INF)
    sk = sink.astype(F32).reshape(A_KV_HEADS, A_GROUP)[None, None, :, :, None, None]
    m = jnp.maximum(s.max(axis=-1, keepdims=True), sk)
    pr = jnp.exp(s - m)
    pr = pr / (pr.sum(axis=-1, keepdims=True) + jnp.exp(sk - m))
    o = jnp.einsum('bnkgij,bnjkd->bnikgd', pr.astype(v.dtype), vb)
    return o.reshape(B, S, A_WIDTH)


def neighbourhood_attention(q, k, v, rpb):
    B, S = q.shape[0], q.shape[1]
    rows = S // GRID_W
    kh = min(NA_WIN_H, rows)
    kw = NA_WIN_W
    r = jnp.arange(rows)
    row_idx = jnp.clip(r - kh // 2, 0, rows - kh)[:, None] + jnp.arange(kh)[None]
    c = jnp.arange(GRID_W)
    cs = jnp.clip(c - kw // 2, 0, GRID_W - kw)
    col_ok = (c[None] >= cs[:, None]) & (c[None] < cs[:, None] + kw)
    row_off = row_idx - r[:, None] + NA_WIN_H - 1
    col_off = jnp.clip(c[None] - c[:, None], -(kw - 1), kw - 1) + kw - 1
    bias = rpb.astype(F32)[:, row_off[:, None, :, None], col_off[None, :, None, :]]
    bias = bias.transpose(1, 0, 2, 3, 4)
    q5 = q.reshape(B, rows, GRID_W, B_HEADS, HEAD_DIM)
    kg = k.reshape(B, rows, GRID_W, B_HEADS, HEAD_DIM)[:, row_idx]
    vg = v.reshape(B, rows, GRID_W, B_HEADS, HEAD_DIM)[:, row_idx]
    s = jnp.einsum('brqhd,brikhd->brhqik', q5, kg).astype(F32) * (HEAD_DIM ** -0.5) + bias[None]
    s = jnp.where(col_ok[:, None, :], s, NEG_INF)
    pr = jax.nn.softmax(s.reshape(B, rows, B_HEADS, GRID_W, kh * GRID_W), axis=-1).reshape(s.shape)
    o = jnp.einsum('brhqik,brikhd->brqhd', pr.astype(v.dtype), vg)
    return o.reshape(B, S, B_WIDTH)


def hyena_filters(L, fw1, fb1, fw2, fb2, freq, fw3):
    t = jnp.linspace(0.0, 1.0, L, dtype=F32)[:, None]
    bands = (HYENA_EMB - 1) // 2
    w = (2.0 * math.pi / L) * jnp.arange(L, dtype=F32)[:, None]
    f = jnp.linspace(1e-4, bands - 1, bands, dtype=F32)[None]
    z = jnp.concatenate([t, jnp.cos(f * w), -jnp.sin(f * w)], axis=-1)
    fr = freq.astype(F32)
    hid = jnp.sin(fr * (z @ fw1.astype(F32) + fb1.astype(F32)))
    hid = jnp.sin(fr * (hid @ fw2.astype(F32) + fb2.astype(F32)))
    h = (hid @ fw3.astype(F32)).reshape(L, 2, HYENA_ORDER, HYENA_WIDTH)
    max_decay = math.log(HYENA_DECAY_TARGET) / HYENA_FAST_PCT
    min_decay = math.log(HYENA_DECAY_TARGET) / HYENA_SLOW_PCT
    deltas = jnp.linspace(min_decay, max_decay, HYENA_WIDTH, dtype=F32)
    decay = jnp.exp(-t * jnp.abs(deltas)[None])
    return h * decay[:, None, None, :]


def hyena_mixer(u, w_in, b_in, conv_w, conv_b, fw1, fb1, fw2, fb2, freq, fw3, fbias, w_out):
    B, L, _ = u.shape
    proj = u @ w_in + b_in
    pp = jnp.pad(proj, ((0, 0), (1, 1), (0, 0)))
    sc = pp[:, :-2] * conv_w[0] + pp[:, 1:-1] * conv_w[1] + pp[:, 2:] * conv_w[2] + conv_b
    x1, x2, z = jnp.split(sc, 3, axis=-1)
    h = hyena_filters(L, fw1, fb1, fw2, fb2, freq, fw3)
    two_sided = jnp.concatenate([h[:1, 0] + h[:1, 1], h[1:, 0],
                                 jnp.zeros((1, HYENA_ORDER, HYENA_WIDTH), F32), h[:0:-1, 1]], axis=0)
    hf = jnp.fft.rfft(two_sided, axis=0)
    zf = z.astype(F32)
    for o, gate in enumerate((x1, x2)):
        conv = jnp.fft.irfft(jnp.fft.rfft(zf, n=2 * L, axis=1) * hf[:, o][None], n=2 * L, axis=1)[:, :L]
        zf = gate.astype(F32) * (conv + zf * fbias[o].astype(F32))
    return zf.astype(u.dtype) @ w_out


def swiglu(x, wg, wu, wd):
    return (jax.nn.silu(x @ wg) * (x @ wu)) @ wd


def moe_swiglu(x2, w_router, wg, wu, wd):
    N, D = x2.shape
    logits = (x2 @ w_router).astype(F32)
    top_v, top_i = lax.top_k(logits, TOP_K)
    gates = jax.nn.softmax(top_v, axis=-1)
    e_flat = top_i.reshape(-1)
    tok_flat = jnp.repeat(jnp.arange(N, dtype=jnp.int32), TOP_K)
    g_flat = gates.reshape(-1)
    order = jnp.argsort(e_flat)
    e_s, tok_s, g_s = e_flat[order], tok_flat[order], g_flat[order]
    counts = jnp.bincount(e_flat, length=N_EXPERTS)
    padded = ((counts + MOE_BLOCK - 1) // MOE_BLOCK) * MOE_BLOCK
    pad_end = jnp.cumsum(padded)
    pad_start = pad_end - padded
    start = jnp.cumsum(counts) - counts
    nk = N * TOP_K
    dest = pad_start[e_s] + jnp.arange(nk) - start[e_s]
    P = ((nk + MOE_BLOCK - 1) // MOE_BLOCK) * MOE_BLOCK + N_EXPERTS * MOE_BLOCK
    row_tok = jnp.full((P,), N, jnp.int32).at[dest].set(tok_s)
    row_gate = jnp.zeros((P,), F32).at[dest].set(g_s)
    nblk = P // MOE_BLOCK
    blk_exp = jnp.minimum(jnp.searchsorted(pad_end, jnp.arange(nblk) * MOE_BLOCK, side='right'),
                          N_EXPERTS - 1)
    x_ext = jnp.concatenate([x2, jnp.zeros((1, D), x2.dtype)], axis=0)
    xs = x_ext[row_tok].reshape(nblk, MOE_BLOCK, D)

    def expert_block(args):
        xb, e = args
        return (jax.nn.silu(xb @ wg[e]) * (xb @ wu[e])) @ wd[e]

    ys = lax.map(expert_block, (xs, blk_exp)).reshape(P, D)
    out = jnp.zeros((N + 1, D), ys.dtype).at[row_tok].add(ys * row_gate[:, None].astype(ys.dtype))
    return out[:N]


def setup_inputs(seed: int = 0) -> dict:
    key = jax.random.key(seed)
    ks = iter(jax.random.split(key, 40))

    def nrm(shape, scale):
        return jax.random.normal(next(ks), shape, F32) * scale

    ne = (DEPTH + 1) // 2
    no = DEPTH // 2
    D = D_MODEL
    W = HYENA_WIDTH
    FH = HYENA_FILTER_HIDDEN
    return {
        'x': nrm((BATCH, SEQ, D), 1.0),
        'p': nrm((DEPTH, BATCH, SEQ, PLE_DIM), 1.0),
        'ln_mix': 1.0 + nrm((DEPTH, D), 0.05),
        'ln_ffn': 1.0 + nrm((DEPTH, D), 0.05),
        'ln_ple': 1.0 + nrm((DEPTH, D), 0.05),
        'final_norm': 1.0 + nrm((D,), 0.05),
        't5_bias': nrm((T5_BUCKETS, A_Q_HEADS), 0.5),
        'w_attn_in': nrm((ne, D, ATTN_IN), D ** -0.5),
        'w_attn_out': nrm((ne, MIX_WIDTH, D), MIX_WIDTH ** -0.5),
        'attn_sink': nrm((ne, A_Q_HEADS), 0.5),
        'na_rpb': nrm((ne, B_HEADS, 2 * NA_WIN_H - 1, 2 * NA_WIN_W - 1), 0.5),
        'w_ffn_gate': nrm((ne, D, D_FF), D ** -0.5),
        'w_ffn_up': nrm((ne, D, D_FF), D ** -0.5),
        'w_ffn_down': nrm((ne, D_FF, D), D_FF ** -0.5),
        'w_hy_in': nrm((no, D, 3 * W), D ** -0.5),
        'b_hy_in': nrm((no, 3 * W), 0.02),
        'w_hy_conv': nrm((no, HYENA_SHORT, 3 * W), HYENA_SHORT ** -0.5),
        'b_hy_conv': nrm((no, 3 * W), 0.02),
        'w_hy_f1': nrm((no, HYENA_EMB, FH), HYENA_EMB ** -0.5),
        'b_hy_f1': nrm((no, FH), 0.1),
        'w_hy_f2': nrm((no, FH, FH), FH ** -0.5),
        'b_hy_f2': nrm((no, FH), 0.1),
        'hy_freq': 1.0 + nrm((no, FH), 0.1),
        'w_hy_f3': nrm((no, FH, 2 * HYENA_ORDER * W), 0.05 * FH ** -0.5),
        'hy_bias': nrm((no, HYENA_ORDER, W), 0.5),
        'w_hy_out': nrm((no, W, D), W ** -0.5),
        'w_router': nrm((no, D, N_EXPERTS), D ** -0.5),
        'w_exp_gate': nrm((no, N_EXPERTS, D, D_FF_EXPERT), D ** -0.5),
        'w_exp_up': nrm((no, N_EXPERTS, D, D_FF_EXPERT), D ** -0.5),
        'w_exp_down': nrm((no, N_EXPERTS, D_FF_EXPERT, D), D_FF_EXPERT ** -0.5),
        'w_ple_proj': nrm((DEPTH, PLE_DIM, D), PLE_DIM ** -0.5),
        'w_ple_gate': nrm((DEPTH, D, D), D ** -0.5),
    }


def reference(x, p, ln_mix, ln_ffn, ln_ple, final_norm, t5_bias, w_attn_in, w_attn_out,
              attn_sink, na_rpb, w_ffn_gate, w_ffn_up, w_ffn_down, w_hy_in, b_hy_in,
              w_hy_conv, b_hy_conv, w_hy_f1, b_hy_f1, w_hy_f2, b_hy_f2, hy_freq, w_hy_f3,
              hy_bias, w_hy_out, w_router, w_exp_gate, w_exp_up, w_exp_down,
              w_ple_proj, w_ple_gate):
    B, S, D = x.shape
    o1 = A_WIDTH
    o2 = o1 + A_KV_WIDTH
    o3 = o2 + A_KV_WIDTH
    o4 = o3 + B_WIDTH
    o5 = o4 + B_WIDTH
    h = x
    for i in range(DEPTH):
        li = i // 2
        hn = rmsnorm(h, ln_mix[i])
        if i % 2 == 0:
            proj = hn @ w_attn_in[li]
            qa, ka, va, qn, kn, vn = jnp.split(proj, [o1, o2, o3, o4, o5], axis=-1)
            oa = window_gqa(qa.reshape(B, S, A_Q_HEADS, HEAD_DIM),
                            ka.reshape(B, S, A_KV_HEADS, HEAD_DIM),
                            va.reshape(B, S, A_KV_HEADS, HEAD_DIM), t5_bias, attn_sink[li])
            ob = neighbourhood_attention(qn.reshape(B, S, B_HEADS, HEAD_DIM),
                                         kn.reshape(B, S, B_HEADS, HEAD_DIM),
                                         vn.reshape(B, S, B_HEADS, HEAD_DIM), na_rpb[li])
            h = h + jnp.concatenate([oa, ob], axis=-1) @ w_attn_out[li]
            h = h + swiglu(rmsnorm(h, ln_ffn[i]), w_ffn_gate[li], w_ffn_up[li], w_ffn_down[li])
        else:
            h = h + hyena_mixer(hn, w_hy_in[li], b_hy_in[li], w_hy_conv[li], b_hy_conv[li],
                                w_hy_f1[li], b_hy_f1[li], w_hy_f2[li], b_hy_f2[li], hy_freq[li],
                                w_hy_f3[li], hy_bias[li], w_hy_out[li])
            hn2 = rmsnorm(h, ln_ffn[i]).reshape(B * S, D)
            h = h + moe_swiglu(hn2, w_router[li], w_exp_gate[li], w_exp_up[li],
                               w_exp_down[li]).reshape(B, S, D)
        gate = jax.nn.sigmoid(rmsnorm(h, ln_ple[i]) @ w_ple_gate[i])
        h = h + gate * (p[i] @ w_ple_proj[i])
    return rmsnorm(h, final_norm)
```

```cpp
#include <hip/hip_runtime.h>
#include <cstdio>
#include <cstdint>

#ifndef MK_ONE_LAUNCH
#define MK_ONE_LAUNCH 1
#endif
#ifndef LAST_PHASE
#define LAST_PHASE 99
#endif

#define GAS __attribute__((address_space(1)))
#define LAS __attribute__((address_space(3)))
typedef unsigned short bf16;
typedef short bf16x8 __attribute__((ext_vector_type(8)));
typedef short bf16x4 __attribute__((ext_vector_type(4)));
typedef float f32x4 __attribute__((ext_vector_type(4)));
typedef float f32x2 __attribute__((ext_vector_type(2)));
typedef unsigned u32x4 __attribute__((ext_vector_type(4)));
typedef unsigned u32x2 __attribute__((ext_vector_type(2)));
typedef int v8i __attribute__((ext_vector_type(8)));
typedef int v4i __attribute__((ext_vector_type(4)));

constexpr int NTOK = 8192, SEQ = 4096, DM = 2048;
constexpr int DFF = 5632, DFFE = 7168, NEXP = 8;
constexpr int HYW = 2048;
constexpr float RMS_EPS = 1e-6f;
constexpr int NWAVES = 8, NTHR = 512;
constexpr int MAXTILES = 72;

constexpr size_t MiB = 1u << 20;
constexpr size_t WS_CTL = 0, CTL_BYTES = 1 * MiB;
constexpr size_t WS_W_QK = 2 * MiB;
constexpr size_t WS_W_V = WS_W_QK + 12 * MiB;
constexpr size_t WS_W_AO = WS_W_V + 5 * MiB;
constexpr size_t WS_W_GU = WS_W_AO + 8 * MiB;
constexpr size_t WS_W_FD = WS_W_GU + 44 * MiB;
constexpr size_t WS_W_PG = WS_W_FD + 22 * MiB;
constexpr size_t WS_W_PP = WS_W_PG + 16 * MiB;
constexpr size_t WS_W_HI = WS_W_PP + 2 * MiB;
constexpr size_t WS_W_HO = WS_W_HI + 24 * MiB;
constexpr size_t WS_W_EGU = WS_W_HO + 8 * MiB;
constexpr size_t WS_W_ED = WS_W_EGU + 448 * MiB;
constexpr size_t WS_H = WS_W_ED + 224 * MiB;
constexpr size_t WS_HN = WS_H + 64 * MiB;
constexpr size_t WS_PP = WS_HN + 32 * MiB;
constexpr size_t WS_PB = WS_PP + 64 * MiB;
constexpr size_t WS_FILT = WS_PB + 8 * MiB;
constexpr size_t WS_AF = WS_FILT + 64 * MiB;
constexpr size_t WS_BF = WS_AF + 2 * MiB;
constexpr size_t WS_SCR = WS_BF + 4 * MiB;
constexpr size_t WS_QA = WS_SCR;
constexpr size_t WS_QN = WS_QA + 16 * MiB;
constexpr size_t WS_KN = WS_QN + 16 * MiB;
constexpr size_t WS_KA = WS_KN + 16 * MiB;
constexpr size_t WS_VAT = WS_KA + 2 * MiB;
constexpr size_t WS_VNT = WS_VAT + 2 * MiB;
constexpr size_t WS_AO = WS_VNT + 16 * MiB;
constexpr size_t WS_MID = WS_AO + 32 * MiB;
constexpr size_t WS_XS = WS_SCR;
constexpr size_t WS_HMID = WS_XS + 72 * MiB;
constexpr size_t WS_Y = WS_HMID + 252 * MiB;
constexpr size_t WS_PROJT = WS_HMID;
constexpr size_t WS_ZFT = WS_PROJT + 96 * MiB;
constexpr size_t WS_ZF = WS_ZFT + 32 * MiB;
constexpr size_t WS_PG8 = WS_Y + 144 * MiB;
constexpr size_t WS_H1 = WS_PG8 + 4 * MiB;
constexpr size_t WS_END = WS_H1 + 1 * MiB;
static_assert(WS_MID + 88 * MiB <= WS_END && WS_ZF + 32 * MiB <= WS_Y, "ws map");
constexpr int CW_BAR = 4096;
constexpr int CW_HIST = 16384;
constexpr int CW_TILEEXP = 20480;
constexpr int CW_TAILMAP = 24576;
constexpr int CW_TAILSP = CW_TAILMAP + 640;
constexpr int CW_TOKE = 32768;
constexpr int CW_TOKG = CW_TOKE + 16384;
constexpr int CW_TOKS = CW_TOKG + 16384;
static_assert((CW_TOKS + 16384) * 4 <= (int)CTL_BYTES, "ctl");

constexpr int RING_BYTES = 131072;
constexpr int LDS_BYTES = 163840;
constexpr int MISC_OFF = LDS_BYTES - 256;

__device__ __forceinline__ unsigned f2bf(float f) { unsigned u = __builtin_bit_cast(unsigned, f); return (u + 0x7fffu + ((u >> 16) & 1u)) >> 16; }
__device__ __forceinline__ unsigned pk2(float lo, float hi) { unsigned r; asm volatile("v_cvt_pk_bf16_f32 %0, %1, %2" : "=v"(r) : "v"(lo), "v"(hi)); return r; }
__device__ __forceinline__ float bf2f(unsigned short b) { return __builtin_bit_cast(float, ((unsigned)b) << 16); }
__device__ __forceinline__ float bflo(unsigned w) { return __builtin_bit_cast(float, w << 16); }
__device__ __forceinline__ float bfhi(unsigned w) { return __builtin_bit_cast(float, w & 0xffff0000u); }
__device__ __forceinline__ unsigned pk4_fp8(float a, float b, float c, float d) { int w = 0; w = __builtin_amdgcn_cvt_pk_fp8_f32(a, b, w, false); w = __builtin_amdgcn_cvt_pk_fp8_f32(c, d, w, true); return (unsigned)w; }
__device__ __forceinline__ float wave_sum(float v) {
#pragma unroll
    for (int o = 1; o < 64; o <<= 1) v += __shfl_xor(v, o);
    return v;
}
#define LDS_WAIT() asm volatile("s_waitcnt lgkmcnt(0)" ::: "memory")
#define VM_WAIT() asm volatile("s_waitcnt vmcnt(0)" ::: "memory")

namespace pg8 {
constexpr int BM = 256, BK = 64, HALF = 128, HTB = HALF * BK * 2, STAGE_BYTES = 8 * HTB, NXCD = 8, WGM = 8;
__host__ __device__ __forceinline__ int lds_byte(int r, int c) { const int st = (r >> 4) * 2 + (c >> 5), rr = r & 15, cc = c & 31, ob = rr * 64 + cc * 2; return st * 1024 + (ob ^ (((ob >> 9) & 1) << 5)); }
__host__ __device__ __forceinline__ void stage_rc(int b, int& R, int& C) { const int st = b / 1024, sb = b % 1024, swz = sb ^ (((sb >> 9) & 1) << 5); R = (st >> 1) * 16 + swz / 64; C = (st & 1) * 32 + (swz % 64) / 2; }
__host__ __device__ __forceinline__ int perm32(int rho) { const int n = rho >> 4, i = rho & 15; return 8 * (i >> 2) + 4 * n + (i & 3); }

struct Unit { int pm, pn, kofs, aux; };
struct Gemm { const bf16* A; const bf16* Bt; int M, N, K, ld; };

struct StaticOrder {
    int nM, nN, nwg, G, c, limit;
    __device__ __forceinline__ void init(int M, int N, int G_, int c_) { nM = M / BM; nN = N / BM; nwg = nM * nN; G = G_; c = c_; limit = nwg; }
    __device__ __forceinline__ void unit_at(int L, Unit& u) const {
        int wgid = L; { const int q = nwg / NXCD, r = nwg % NXCD, xcd = wgid % NXCD, off = wgid / NXCD; wgid = (xcd < r ? xcd * (q + 1) : r * (q + 1) + (xcd - r) * q) + off; }
        const int nig = WGM * nN, gid = wgid / nig, fm = gid * WGM, gsz = (nM - fm) < WGM ? (nM - fm) : WGM;
        u.pm = fm + ((wgid % nig) % gsz); u.pn = (wgid % nig) / gsz; u.kofs = 0; u.aux = 0;
    }
    __device__ __forceinline__ bool next(int i, Unit& u) const {
        const long L = (long)i * G + c; if (L >= limit) return false;
        unit_at((int)L, u); return true;
    }
    __device__ __forceinline__ unsigned boffs(const Gemm& g, const Unit& u, unsigned tstep) const { return (unsigned)u.pn * tstep; }
};
struct GroupedOrder : StaticOrder {
    const int* tile_exp; size_t estride;
    __device__ __forceinline__ unsigned boffs(const Gemm& g, const Unit& u, unsigned tstep) const {
        const int e = __builtin_amdgcn_readfirstlane(tile_exp[u.pm]);
        return (unsigned)e * (unsigned)(estride * 2) + (unsigned)u.pn * tstep; }
};
struct TailOrder : GroupedOrder {
    int first, ntail, S, kslice;
    __device__ __forceinline__ bool next(int i, Unit& u) const {
        const long j = (long)i * G + c; if (j >= (long)ntail * S) return false;
        const int tu = (int)(j / S), sl = (int)(j % S); unit_at(first + tu, u); u.kofs = sl * kslice; u.aux = (int)j; return true;
    }
};

template <class Epi, class Sched>
__device__ __forceinline__ void gemm_phase(LAS unsigned char* lds, const Gemm g, const Sched& S, const Epi& E) {
    int tid = threadIdx.x; asm volatile("" : "+v"(tid));
    const int wid = __builtin_amdgcn_readfirstlane(tid >> 6), lane = tid & 63, wr = wid >> 2, wc = wid & 3, fr = lane & 15, fq = lane >> 4;
    const int K = g.ld, nt = g.K / BK;
    unsigned voffA, voffB;
    { int R, C; stage_rc(tid * 16, R, C); const int Rb = Epi::PERM ? ((R & ~31) + perm32(R & 31)) : R;
        voffA = (unsigned)(R * K + C) * 2u; voffB = (unsigned)(Rb * K + C) * 2u; }
    const unsigned qstep = 64u * (unsigned)K * 2u;
    const unsigned kstep = (unsigned)(BK * 2);
    const unsigned hstep = (unsigned)HALF * (unsigned)K * 2u;
    const unsigned tstep = 2u * hstep;
    const __amdgpu_buffer_rsrc_t rsA = __builtin_amdgcn_make_buffer_rsrc((void*)g.A, 0, 0x7fffffff, 0x00020000);
    const __amdgpu_buffer_rsrc_t rsB = __builtin_amdgcn_make_buffer_rsrc((void*)g.Bt, 0, 0x7fffffff, 0x00020000);
    const unsigned ldsw = (unsigned)wid * 1024u;
    const int aoff = lds_byte(wr * 64 + fr, fq * 8), boff = lds_byte(wc * 32 + fr, fq * 8);
#define PG8_SA(b, h) (((b) * 2 + (h)) * HTB)
#define PG8_SB(b, h) ((4 + (b) * 2 + (h)) * HTB)
#define PG8_STAGE(bufoff, rs, soff, voff) do { _Pragma("unroll") for (int _i = 0; _i < 2; ++_i) \
        __builtin_amdgcn_raw_ptr_buffer_load_lds(rs, (LAS unsigned*)(lds + (bufoff) + ldsw + _i * 8192), 16, (voff), (soff) + _i * qstep, 0, 0); } while (0)
#define PG8_LDA(dst, b, h) do { _Pragma("unroll") for (int m = 0; m < 4; ++m) { const v4i _lo = *(const LAS v4i*)(lds + PG8_SA(b, h) + aoff + m * 2048), _hi = *(const LAS v4i*)(lds + PG8_SA(b, h) + aoff + m * 2048 + 1024); \
        dst[m] = __builtin_shufflevector(_lo, _hi, 0, 1, 2, 3, 4, 5, 6, 7); } } while (0)
#define PG8_LDB(dst, b, h) do { _Pragma("unroll") for (int n = 0; n < 2; ++n) { const v4i _lo = *(const LAS v4i*)(lds + PG8_SB(b, h) + boff + n * 2048), _hi = *(const LAS v4i*)(lds + PG8_SB(b, h) + boff + n * 2048 + 1024); \
        dst[n] = __builtin_shufflevector(_lo, _hi, 0, 1, 2, 3, 4, 5, 6, 7); } } while (0)
#define PG8_MMA(ai, bj, At, Bt) do { __builtin_amdgcn_s_setprio(1); \
        if constexpr (Epi::FP8) { _Pragma("unroll") for (int m = 0; m < 4; ++m) _Pragma("unroll") for (int n = 0; n < 2; ++n) \
            acc[ai][bj][m][n] = Epi::TRANS ? __builtin_amdgcn_mfma_scale_f32_16x16x128_f8f6f4(Bt[n], At[m], acc[ai][bj][m][n], 0, 0, 0, 0x7f7f7f7f, 0, 0x7f7f7f7f) \
                                           : __builtin_amdgcn_mfma_scale_f32_16x16x128_f8f6f4(At[m], Bt[n], acc[ai][bj][m][n], 0, 0, 0, 0x7f7f7f7f, 0, 0x7f7f7f7f); } \
        else { _Pragma("unroll") for (int m = 0; m < 4; ++m) _Pragma("unroll") for (int n = 0; n < 2; ++n) { \
            const bf16x8 a0 = __builtin_bit_cast(bf16x8, __builtin_shufflevector(At[m], At[m], 0, 1, 2, 3)), a1 = __builtin_bit_cast(bf16x8, __builtin_shufflevector(At[m], At[m], 4, 5, 6, 7)), \
                         b0 = __builtin_bit_cast(bf16x8, __builtin_shufflevector(Bt[n], Bt[n], 0, 1, 2, 3)), b1 = __builtin_bit_cast(bf16x8, __builtin_shufflevector(Bt[n], Bt[n], 4, 5, 6, 7)); \
            acc[ai][bj][m][n] = Epi::TRANS ? __builtin_amdgcn_mfma_f32_16x16x32_bf16(b0, a0, acc[ai][bj][m][n], 0, 0, 0) : __builtin_amdgcn_mfma_f32_16x16x32_bf16(a0, b0, acc[ai][bj][m][n], 0, 0, 0); \
            acc[ai][bj][m][n] = Epi::TRANS ? __builtin_amdgcn_mfma_f32_16x16x32_bf16(b1, a1, acc[ai][bj][m][n], 0, 0, 0) : __builtin_amdgcn_mfma_f32_16x16x32_bf16(a1, b1, acc[ai][bj][m][n], 0, 0, 0); } } \
        __builtin_amdgcn_s_setprio(0); } while (0)
#define PG8_WAIT_V(n) asm volatile("s_waitcnt vmcnt(" #n ")" ::: "memory")
#define PG8_WAIT_L(n) asm volatile("s_waitcnt lgkmcnt(" #n ")" ::: "memory")
#define PG8_BAR __builtin_amdgcn_s_barrier()
#define PG8_SCHED __builtin_amdgcn_sched_barrier(0)
    Unit cur, nxt; int ui = 0;
    if (!S.next(0, cur)) return;
    f32x4 acc[2][2][4][2];
#pragma unroll
    for (int a = 0; a < 2; ++a)
#pragma unroll
        for (int b = 0; b < 2; ++b)
#pragma unroll
            for (int m = 0; m < 4; ++m)
#pragma unroll
                for (int n = 0; n < 2; ++n) acc[a][b][m][n] = (f32x4){0.f, 0.f, 0.f, 0.f};
    v8i At[4], B0[2], B1[2];
    unsigned cA = (unsigned)cur.pm * tstep + (unsigned)cur.kofs * 2u, cB = S.boffs(g, cur, tstep) + (unsigned)cur.kofs * 2u;
    PG8_STAGE(PG8_SB(0, 0), rsB, cB, voffB); PG8_STAGE(PG8_SB(0, 1), rsB, cB + hstep, voffB); PG8_STAGE(PG8_SA(0, 0), rsA, cA, voffA); PG8_STAGE(PG8_SA(0, 1), rsA, cA + hstep, voffA);
    if (wr == 1) PG8_BAR;
    PG8_WAIT_V(2); PG8_BAR;
    PG8_STAGE(PG8_SB(1, 0), rsB, cB + kstep, voffB); PG8_STAGE(PG8_SA(1, 0), rsA, cA + kstep, voffA); PG8_STAGE(PG8_SB(1, 1), rsB, cB + hstep + kstep, voffB);
    PG8_WAIT_V(6); PG8_BAR;
    for (;;) {
        const bool has_next = S.next(ui + 1, nxt);
        const unsigned nA = has_next ? (unsigned)nxt.pm * tstep + (unsigned)nxt.kofs * 2u : cA, nB = has_next ? S.boffs(g, nxt, tstep) + (unsigned)nxt.kofs * 2u : cB;
        for (int t = 0; t < nt; t += 2) {
            const bool last = (t == nt - 2);
            const unsigned a1 = cA + (unsigned)(t + 1) * kstep;
            const unsigned a2 = last ? nA : cA + (unsigned)(t + 2) * kstep, b2 = last ? nB : cB + (unsigned)(t + 2) * kstep;
            const unsigned a3 = a2 + kstep, b3 = b2 + kstep;
            PG8_LDB(B0, 0, 0); PG8_LDB(B1, 0, 1); PG8_SCHED; PG8_LDA(At, 0, 0); PG8_STAGE(PG8_SA(1, 1), rsA, a1 + hstep, voffA);
            PG8_WAIT_V(8); PG8_WAIT_L(0); PG8_BAR; PG8_MMA(0, 0, At, B0); PG8_MMA(0, 1, At, B1); PG8_BAR; PG8_SCHED;
            PG8_LDA(At, 0, 1); PG8_STAGE(PG8_SB(0, 0), rsB, b2, voffB); PG8_STAGE(PG8_SB(0, 1), rsB, b2 + hstep, voffB); PG8_STAGE(PG8_SA(0, 0), rsA, a2, voffA);
            PG8_WAIT_V(8); PG8_WAIT_L(0); PG8_BAR; PG8_MMA(1, 0, At, B0); PG8_MMA(1, 1, At, B1); PG8_BAR; PG8_SCHED;
            PG8_LDB(B0, 1, 0); PG8_LDB(B1, 1, 1); PG8_SCHED; PG8_LDA(At, 1, 0); PG8_STAGE(PG8_SA(0, 1), rsA, a2 + hstep, voffA);
            PG8_WAIT_V(8); PG8_WAIT_L(0); PG8_BAR; PG8_MMA(0, 0, At, B0); PG8_MMA(0, 1, At, B1); PG8_BAR; PG8_SCHED;
            PG8_LDA(At, 1, 1); PG8_STAGE(PG8_SB(1, 0), rsB, b3, voffB); PG8_STAGE(PG8_SB(1, 1), rsB, b3 + hstep, voffB); PG8_STAGE(PG8_SA(1, 0), rsA, a3, voffA);
            PG8_WAIT_V(8); PG8_WAIT_L(0); PG8_BAR; PG8_MMA(1, 0, At, B0); PG8_MMA(1, 1, At, B1); PG8_BAR; PG8_SCHED;
        }
        if (wr == 0) PG8_BAR;
        { int tz = threadIdx.x; asm volatile("" : "+v"(tz));
          const int ewid = tz >> 6, elane = tz & 63; E(acc, cur, ewid >> 2, ewid & 3, elane & 15, elane >> 4); }
        if (!has_next) break;
#pragma unroll
        for (int a = 0; a < 2; ++a)
#pragma unroll
            for (int b = 0; b < 2; ++b)
#pragma unroll
                for (int m = 0; m < 4; ++m)
#pragma unroll
                    for (int n = 0; n < 2; ++n) acc[a][b][m][n] = (f32x4){0.f, 0.f, 0.f, 0.f};
        cur = nxt; cA = nA; cB = nB; ++ui;
        if (wr == 1) PG8_BAR;
    }
    PG8_WAIT_V(0);
    PG8_BAR;
#undef PG8_SA
#undef PG8_SB
#undef PG8_STAGE
#undef PG8_LDA
#undef PG8_LDB
#undef PG8_MMA
#undef PG8_WAIT_V
#undef PG8_WAIT_L
#undef PG8_BAR
#undef PG8_SCHED
}

template <bool F8> struct EpiBf16T {
    static constexpr bool PERM = true, TRANS = true, FP8 = F8;
    bf16* O; int ldc; int split_cols; size_t split_stride; float sc;
    __device__ __forceinline__ void operator()(const f32x4 (&acc)[2][2][4][2], const Unit& u, int wr, int wc, int fr, int fq) const {
        const int row0 = u.pm * BM + wr * 64 + fr; int colt = u.pn * BM; bf16* base = O;
        if (split_cols) { const int t = colt / split_cols; base += (size_t)t * split_stride; colt -= t * split_cols; }
        const int col0 = colt + wc * 32 + 8 * fq;
#pragma unroll
        for (int ai = 0; ai < 2; ++ai)
#pragma unroll
            for (int m = 0; m < 4; ++m) { bf16* rowp = base + (size_t)(row0 + ai * HALF + m * 16) * ldc + col0;
#pragma unroll
                for (int bj = 0; bj < 2; ++bj) { const f32x4 v0 = acc[ai][bj][m][0] * sc, v1 = acc[ai][bj][m][1] * sc;
                    u32x4 w; w.x = pk2(v0[0], v0[1]); w.y = pk2(v0[2], v0[3]); w.z = pk2(v1[0], v1[1]); w.w = pk2(v1[2], v1[3]);
                    *(u32x4*)(rowp + bj * HALF) = w; } }
    }
};
typedef EpiBf16T<false> EpiBf16;
template <bool F8> struct EpiResidT {
    static constexpr bool PERM = false, TRANS = true, FP8 = F8;
    const float* base; float* out; int ldc; float sc;
    __device__ __forceinline__ void operator()(const f32x4 (&acc)[2][2][4][2], const Unit& u, int wr, int wc, int fr, int fq) const {
        const int row0 = u.pm * BM + wr * 64 + fr, col0 = u.pn * BM + wc * 32 + 4 * fq;
#pragma unroll
        for (int ai = 0; ai < 2; ++ai)
#pragma unroll
            for (int m = 0; m < 4; ++m) { const size_t off = (size_t)(row0 + ai * HALF + m * 16) * ldc + col0;
#pragma unroll
                for (int bj = 0; bj < 2; ++bj)
#pragma unroll
                    for (int n = 0; n < 2; ++n) { const f32x4 b = *(const f32x4*)(base + off + bj * HALF + n * 16); *(f32x4*)(out + off + bj * HALF + n * 16) = b + acc[ai][bj][m][n] * sc; } }
    }
};
typedef EpiResidT<false> EpiResid;
struct EpiF32 {
    static constexpr bool PERM = false, TRANS = true, FP8 = false;
    float* out; int ldc;
    __device__ __forceinline__ void operator()(const f32x4 (&acc)[2][2][4][2], const Unit& u, int wr, int wc, int fr, int fq) const {
        const int row0 = u.pm * BM + wr * 64 + fr, col0 = u.pn * BM + wc * 32 + 4 * fq;
#pragma unroll
        for (int ai = 0; ai < 2; ++ai)
#pragma unroll
            for (int m = 0; m < 4; ++m) { const size_t off = (size_t)(row0 + ai * HALF + m * 16) * ldc + col0;
#pragma unroll
                for (int bj = 0; bj < 2; ++bj)
#pragma unroll
                    for (int n = 0; n < 2; ++n) *(f32x4*)(out + off + bj * HALF + n * 16) = acc[ai][bj][m][n]; }
    }
};
struct EpiPartTile {
    static constexpr bool PERM = false, TRANS = true, FP8 = false;
    float* YP;
    __device__ __forceinline__ void operator()(const f32x4 (&acc)[2][2][4][2], const Unit& u, int wr, int wc, int fr, int fq) const {
        float* base = YP + (size_t)u.aux * 65536 + (size_t)(wr * 64 + fr) * 256 + wc * 32 + 4 * fq;
#pragma unroll
        for (int ai = 0; ai < 2; ++ai)
#pragma unroll
            for (int m = 0; m < 4; ++m)
#pragma unroll
                for (int bj = 0; bj < 2; ++bj)
#pragma unroll
                    for (int n = 0; n < 2; ++n) *(f32x4*)(base + (size_t)(ai * HALF + m * 16) * 256 + bj * HALF + n * 16) = acc[ai][bj][m][n];
    }
};
struct EpiSwiGLU {
    static constexpr bool PERM = true, TRANS = true, FP8 = false;
    bf16* O; int ldc;
    __device__ __forceinline__ void operator()(const f32x4 (&acc)[2][2][4][2], const Unit& u, int wr, int wc, int fr, int fq) const {
        const int row0 = u.pm * BM + wr * 64 + fr, col0 = u.pn * HALF + wc * 32 + 8 * fq;
#pragma unroll
        for (int ai = 0; ai < 2; ++ai)
#pragma unroll
            for (int m = 0; m < 4; ++m) { bf16* rowp = O + (size_t)(row0 + ai * HALF + m * 16) * ldc + col0;
                float o[8];
#pragma unroll
                for (int n = 0; n < 2; ++n)
#pragma unroll
                    for (int i = 0; i < 4; ++i) { const float gt = acc[ai][0][m][n][i], up = acc[ai][1][m][n][i]; o[n * 4 + i] = gt * up * __builtin_amdgcn_rcpf(1.0f + __expf(-gt)); }
                u32x4 w; w.x = pk2(o[0], o[1]); w.y = pk2(o[2], o[3]); w.z = pk2(o[4], o[5]); w.w = pk2(o[6], o[7]);
                *(u32x4*)rowp = w; }
    }
};
struct EpiSwiGLU8 {
    static constexpr bool PERM = true, TRANS = true, FP8 = true;
    unsigned char* O; int ldc;
    __device__ __forceinline__ void operator()(const f32x4 (&acc)[2][2][4][2], const Unit& u, int wr, int wc, int fr, int fq) const {
        const int row0 = u.pm * BM + wr * 64 + fr, col0 = u.pn * HALF + wc * 32 + 8 * fq;
#pragma unroll
        for (int ai = 0; ai < 2; ++ai)
#pragma unroll
            for (int m = 0; m < 4; ++m) { unsigned char* rowp = O + (size_t)(row0 + ai * HALF + m * 16) * ldc + col0;
                float o[8];
#pragma unroll
                for (int n = 0; n < 2; ++n)
#pragma unroll
                    for (int i = 0; i < 4; ++i) { const float gt = acc[ai][0][m][n][i] * (1.0f / 64.0f), up = acc[ai][1][m][n][i] * (1.0f / 64.0f); o[n * 4 + i] = gt * up * __builtin_amdgcn_rcpf(1.0f + __expf(-gt)); }
                u32x2 w; w.x = pk4_fp8(o[0], o[1], o[2], o[3]); w.y = pk4_fp8(o[4], o[5], o[6], o[7]);
                *(u32x2*)rowp = w; }
    }
};
struct EpiF32s8 {
    static constexpr bool PERM = false, TRANS = true, FP8 = true;
    float* out; int ldc; float scale;
    __device__ __forceinline__ void operator()(const f32x4 (&acc)[2][2][4][2], const Unit& u, int wr, int wc, int fr, int fq) const {
        const int row0 = u.pm * BM + wr * 64 + fr, col0 = u.pn * BM + wc * 32 + 4 * fq;
#pragma unroll
        for (int ai = 0; ai < 2; ++ai)
#pragma unroll
            for (int m = 0; m < 4; ++m) { const size_t off = (size_t)(row0 + ai * HALF + m * 16) * ldc + col0;
#pragma unroll
                for (int bj = 0; bj < 2; ++bj)
#pragma unroll
                    for (int n = 0; n < 2; ++n) *(f32x4*)(out + off + bj * HALF + n * 16) = acc[ai][bj][m][n] * scale; }
    }
};
struct EpiPartTile8 {
    static constexpr bool PERM = false, TRANS = true, FP8 = true;
    float* YP; float scale;
    __device__ __forceinline__ void operator()(const f32x4 (&acc)[2][2][4][2], const Unit& u, int wr, int wc, int fr, int fq) const {
        float* base = YP + (size_t)u.aux * 65536 + (size_t)(wr * 64 + fr) * 256 + wc * 32 + 4 * fq;
#pragma unroll
        for (int ai = 0; ai < 2; ++ai)
#pragma unroll
            for (int m = 0; m < 4; ++m)
#pragma unroll
                for (int bj = 0; bj < 2; ++bj)
#pragma unroll
                    for (int n = 0; n < 2; ++n) *(f32x4*)(base + (size_t)(ai * HALF + m * 16) * 256 + bj * HALF + n * 16) = acc[ai][bj][m][n] * scale;
    }
};
struct EpiPle {
    static constexpr bool PERM = false, TRANS = true, FP8 = false;
    float* h; const bf16* pp; int ldc;
    __device__ __forceinline__ void operator()(const f32x4 (&acc)[2][2][4][2], const Unit& u, int wr, int wc, int fr, int fq) const {
        const int row0 = u.pm * BM + wr * 64 + fr, col0 = u.pn * BM + wc * 32 + 4 * fq;
#pragma unroll
        for (int ai = 0; ai < 2; ++ai)
#pragma unroll
            for (int m = 0; m < 4; ++m) { const size_t off = (size_t)(row0 + ai * HALF + m * 16) * ldc + col0;
#pragma unroll
                for (int bj = 0; bj < 2; ++bj)
#pragma unroll
                    for (int n = 0; n < 2; ++n) { const size_t o2 = off + bj * HALF + n * 16; const f32x4 b = *(const f32x4*)(h + o2); const u32x2 pw = *(const u32x2*)(pp + o2);
                        const f32x4 a = acc[ai][bj][m][n]; f32x4 r;
                        r[0] = b[0] + bflo(pw.x) * __builtin_amdgcn_rcpf(1.0f + __expf(-a[0])); r[1] = b[1] + bfhi(pw.x) * __builtin_amdgcn_rcpf(1.0f + __expf(-a[1]));
                        r[2] = b[2] + bflo(pw.y) * __builtin_amdgcn_rcpf(1.0f + __expf(-a[2])); r[3] = b[3] + bfhi(pw.y) * __builtin_amdgcn_rcpf(1.0f + __expf(-a[3]));
                        *(f32x4*)(h + o2) = r; } }
    }
};
struct EpiPle8 {
    static constexpr bool PERM = false, TRANS = true, FP8 = true;
    float* h; const bf16* pp; int ldc;
    __device__ __forceinline__ void operator()(const f32x4 (&acc)[2][2][4][2], const Unit& u, int wr, int wc, int fr, int fq) const {
        const int row0 = u.pm * BM + wr * 64 + fr, col0 = u.pn * BM + wc * 32 + 4 * fq;
#pragma unroll
        for (int ai = 0; ai < 2; ++ai)
#pragma unroll
            for (int m = 0; m < 4; ++m) { const size_t off = (size_t)(row0 + ai * HALF + m * 16) * ldc + col0;
#pragma unroll
                for (int bj = 0; bj < 2; ++bj)
#pragma unroll
                    for (int n = 0; n < 2; ++n) { const size_t o2 = off + bj * HALF + n * 16; const f32x4 b = *(const f32x4*)(h + o2); const u32x2 pw = *(const u32x2*)(pp + o2);
                        const f32x4 a = acc[ai][bj][m][n] * (1.0f / 64.0f); f32x4 r;
                        r[0] = b[0] + bflo(pw.x) * __builtin_amdgcn_rcpf(1.0f + __expf(-a[0])); r[1] = b[1] + bfhi(pw.x) * __builtin_amdgcn_rcpf(1.0f + __expf(-a[1]));
                        r[2] = b[2] + bflo(pw.y) * __builtin_amdgcn_rcpf(1.0f + __expf(-a[2])); r[3] = b[3] + bfhi(pw.y) * __builtin_amdgcn_rcpf(1.0f + __expf(-a[3]));
                        *(f32x4*)(h + o2) = r; } }
    }
};
template <bool F8> struct EpiVT {
    static constexpr bool PERM = false, TRANS = false, FP8 = F8;
    bf16* KA; bf16* VAT; bf16* VNT; float sc;
    __device__ __forceinline__ void operator()(const f32x4 (&acc)[2][2][4][2], const Unit& u, int wr, int wc, int fr, int fq) const {
        const int b = u.pm >> 4;
        const int s0 = (u.pm & 15) * BM + wr * 64 + 4 * fq;
#pragma unroll
        for (int bj = 0; bj < 2; ++bj)
#pragma unroll
            for (int n = 0; n < 2; ++n) { const int cl = bj * HALF + wc * 32 + n * 16 + fr;
#pragma unroll
                for (int ai = 0; ai < 2; ++ai)
#pragma unroll
                    for (int m = 0; m < 4; ++m) { const f32x4 v = acc[ai][bj][m][n] * sc; const int s = s0 + ai * HALF + m * 16;
                        if (u.pn == 0 && bj == 0) {
                            bf16* p = KA + (size_t)(b * SEQ + s) * 128 + cl;
                            p[0] = (bf16)f2bf(v[0]); p[128] = (bf16)f2bf(v[1]); p[256] = (bf16)f2bf(v[2]); p[384] = (bf16)f2bf(v[3]);
                        } else {
                            bf16* p = (u.pn == 0) ? VAT + ((size_t)b * 128 + (cl - 128)) * SEQ + s : VNT + ((size_t)b * 1024 + (u.pn - 1) * BM + cl) * SEQ + s;
                            u32x2 w; w.x = pk2(v[0], v[1]); w.y = pk2(v[2], v[3]); *(u32x2*)p = w;
                        } } }
    }
};
struct EpiProjT {
    static constexpr bool PERM = false, TRANS = false, FP8 = false;
    bf16* OT; const float* bias; int ldt;
    __device__ __forceinline__ void operator()(const f32x4 (&acc)[2][2][4][2], const Unit& u, int wr, int wc, int fr, int fq) const {
        const int r0 = u.pm * BM + wr * 64 + 4 * fq;
#pragma unroll
        for (int bj = 0; bj < 2; ++bj)
#pragma unroll
            for (int n = 0; n < 2; ++n) { const int col = u.pn * BM + bj * HALF + wc * 32 + n * 16 + fr; const float bv = bias[col];
                bf16* cp = OT + (size_t)col * ldt + r0;
#pragma unroll
                for (int ai = 0; ai < 2; ++ai)
#pragma unroll
                    for (int m = 0; m < 4; ++m) { const f32x4 v = acc[ai][bj][m][n]; u32x2 w; w.x = pk2(v[0] + bv, v[1] + bv); w.y = pk2(v[2] + bv, v[3] + bv);
                        *(u32x2*)(cp + ai * HALF + m * 16) = w; } }
    }
};
struct EpiFilt {
    static constexpr bool PERM = false, TRANS = false, FP8 = false;
    bf16* F;
    __device__ __forceinline__ void operator()(const f32x4 (&acc)[2][2][4][2], const Unit& u, int wr, int wc, int fr, int fq) const {
        const int t00 = u.pm * BM + wr * 64 + 4 * fq;
        const int colb = u.pn * BM + wc * 32 + fr;
#pragma unroll
        for (int ai = 0; ai < 2; ++ai)
#pragma unroll
            for (int m = 0; m < 4; ++m) { const int t0 = t00 + ai * HALF + m * 16; float tl[4];
#pragma unroll
                for (int j = 0; j < 4; ++j) tl[j] = (float)(t0 + j) * (-1.0f / 4095.0f);
#pragma unroll
                for (int bj = 0; bj < 2; ++bj)
#pragma unroll
                    for (int n = 0; n < 2; ++n) { const int col = colb + bj * HALF + n * 16; const int dir = col >> 12, o = (col >> 11) & 1, c = col & 2047;
                        const float adl = 3.0701134573253944f + (float)c * ((15.350567286626973f - 3.0701134573253944f) / 2047.0f);
                        bf16* cp = F + ((size_t)(o * 2048 + c) * 2 + dir) * 4096 + t0;
                        const f32x4 v = acc[ai][bj][m][n];
                        u32x2 w; w.x = pk2(v[0] * __expf(adl * tl[0]), v[1] * __expf(adl * tl[1])); w.y = pk2(v[2] * __expf(adl * tl[2]), v[3] * __expf(adl * tl[3])); *(u32x2*)cp = w; }
                asm volatile("" ::: "memory"); }
    }
};
}

#define XB_TMO      128
#define XB_XCNT(j)  (256  + 64 * (j))
#define XB_XSUB(j)  (1280 + 64 * (j))
#define XB_XGEN(j)  (2304 + 64 * (j))
#define XB_TOP      3328
#define XB_TOPGEN   3392
#define XCD_BAR_WORDS 3456
#define XB_SPIN_CAP (1u << 18)
__device__ __forceinline__ unsigned xb_ld(unsigned* p)              { return __hip_atomic_load(p, __ATOMIC_RELAXED, __HIP_MEMORY_SCOPE_AGENT); }
__device__ __forceinline__ unsigned xb_add(unsigned* p, unsigned v) { return __hip_atomic_fetch_add(p, v, __ATOMIC_RELAXED, __HIP_MEMORY_SCOPE_AGENT); }
__device__ __forceinline__ unsigned xb_xcc_id() { return (unsigned)__builtin_amdgcn_s_getreg((3 << 11) | 20) & 0xFu; }
#define XB_SPIN(cond, bar) do { unsigned _sp = 0; while (cond) { __builtin_amdgcn_s_sleep(1); \
    if ((++_sp & 255u) == 0u) { if (xb_ld(&(bar)[XB_TMO])) break; if (_sp > XB_SPIN_CAP) { atomicAdd(&(bar)[XB_TMO], 1u); break; } } } } while (0)
struct XcdBarrier { unsigned* bar; unsigned x; volatile LAS unsigned* st; };
__device__ __forceinline__ XcdBarrier xcd_barrier_post(unsigned* bar, volatile LAS unsigned* st) {
    XcdBarrier b; b.bar = bar; b.x = xb_xcc_id(); b.st = st;
    if (threadIdx.x == 0) (void)xb_add(&bar[XB_XCNT(b.x)], 1u);
    return b;
}
__device__ __forceinline__ void xcd_barrier_complete(unsigned* bar, unsigned x, unsigned& nloc, unsigned& nx) {
    const unsigned G = gridDim.x * gridDim.y * gridDim.z;
    unsigned sum, cnt, mine, sp = 0u;
    for (;;) {
        sum = 0u; cnt = 0u; mine = 0u;
#pragma unroll
        for (unsigned j = 0; j < 16; ++j) { const unsigned c = xb_ld(&bar[XB_XCNT(j)]); sum += c; cnt += (c > 0u) ? 1u : 0u; mine = (j == x) ? c : mine; }
        if (sum == G) break;
        __builtin_amdgcn_s_sleep(1);
        if ((++sp & 255u) == 0u) { if (xb_ld(&bar[XB_TMO])) break; if (sp > XB_SPIN_CAP) { atomicAdd(&bar[XB_TMO], 1u); break; } }
    }
    nloc = mine > 0u ? mine : 1u; nx = cnt > 0u ? cnt : 1u;
}
__device__ __forceinline__ void xcd_barrier(const XcdBarrier& b) {
    asm volatile("s_waitcnt vmcnt(0)" ::: "memory");
    __syncthreads();
    if (threadIdx.x == 0) {
        unsigned* bar = b.bar;
        __builtin_amdgcn_s_waitcnt(0);
        unsigned nloc = b.st[0], nx = b.st[1];
        if (nloc == 0u) { xcd_barrier_complete(bar, b.x, nloc, nx); b.st[0] = nloc; b.st[1] = nx; }
        const unsigned old = xb_add(&bar[XB_XSUB(b.x)], 1u);
        const unsigned gen = old / nloc;
        if (old + 1u == (gen + 1u) * nloc) {
            __builtin_amdgcn_fence(__ATOMIC_RELEASE, "agent");
            asm volatile("s_waitcnt vmcnt(0)" ::: "memory");
            const unsigned og = xb_add(&bar[XB_TOP], 1u);
            const unsigned tg = og / nx;
            if (og + 1u == (tg + 1u) * nx) xb_add(&bar[XB_TOPGEN], 1u);
            else XB_SPIN(xb_ld(&bar[XB_TOPGEN]) == tg, bar);
            __builtin_amdgcn_fence(__ATOMIC_ACQUIRE, "agent");
            xb_add(&bar[XB_XGEN(b.x)], 1u);
            asm volatile("s_waitcnt vmcnt(0)" ::: "memory");
        } else {
            XB_SPIN(xb_ld(&bar[XB_XGEN(b.x)]) == gen, bar);
            __builtin_amdgcn_fence(__ATOMIC_ACQUIRE, "agent");
            asm volatile("s_waitcnt vmcnt(0)" ::: "memory");
        }
    }
    __syncthreads();
}

struct Args { const float* in[32]; float* out; unsigned char* ws; int ph_lo, ph_hi; };
enum { I_X = 0, I_P, I_LN_MIX, I_LN_FFN, I_LN_PLE, I_FINAL, I_T5, I_W_AIN, I_W_AOUT, I_SINK, I_RPB, I_W_FG, I_W_FU, I_W_FD, I_W_HI, I_B_HI, I_W_HC, I_B_HC,
       I_W_F1, I_B_F1, I_W_F2, I_B_F2, I_FREQ, I_W_F3, I_HYB, I_W_HO, I_W_RT, I_W_EG, I_W_EU, I_W_ED, I_W_PP, I_W_PG };

__device__ __forceinline__ void cvt_item(const float* W, int K, int N, bf16* WT, int k0, int n0, int drow0, LAS float* scr, int lane) {
    float tv[32];
    const float* wp = W + (size_t)(k0 + (lane >> 5)) * N + n0 + (lane & 31);
#pragma unroll
    for (int i = 0; i < 32; ++i) tv[i] = __builtin_nontemporal_load(wp + (size_t)(2 * i) * N);
#pragma unroll
    for (int i = 0; i < 32; ++i) scr[(2 * i + (lane >> 5)) * 33 + (lane & 31)] = tv[i];
    LDS_WAIT(); asm volatile("" ::: "memory");
    const int c = lane & 7;
#pragma unroll
    for (int j = 0; j < 4; ++j) { const int n = (lane >> 3) + 8 * j; const LAS float* s = scr + (8 * c) * 33 + n;
        u32x4 o; o.x = pk2(s[0 * 33], s[1 * 33]); o.y = pk2(s[2 * 33], s[3 * 33]); o.z = pk2(s[4 * 33], s[5 * 33]); o.w = pk2(s[6 * 33], s[7 * 33]);
        __builtin_nontemporal_store(o, (u32x4*)(WT + (size_t)(drow0 + n) * K + k0 + 8 * c)); }
    LDS_WAIT(); asm volatile("" ::: "memory");
}
__device__ __forceinline__ void cvt_item8(const float* W, int K, int N, unsigned char* WT, int k0, int n0, int drow0, LAS float* scr, int lane) {
    float tv[64];
    const float* wp = W + (size_t)(k0 + (lane >> 5)) * N + n0 + (lane & 31);
#pragma unroll
    for (int i = 0; i < 64; ++i) tv[i] = __builtin_nontemporal_load(wp + (size_t)(2 * i) * N);
#pragma unroll
    for (int i = 0; i < 64; ++i) scr[(2 * i + (lane >> 5)) * 33 + (lane & 31)] = tv[i];
    LDS_WAIT(); asm volatile("" ::: "memory");
    const int c = lane & 7;
#pragma unroll
    for (int j = 0; j < 4; ++j) { const int n = (lane >> 3) + 8 * j; const LAS float* sp = scr + (16 * c) * 33 + n;
        u32x4 o;
        o.x = pk4_fp8(64.f * sp[0 * 33], 64.f * sp[1 * 33], 64.f * sp[2 * 33], 64.f * sp[3 * 33]); o.y = pk4_fp8(64.f * sp[4 * 33], 64.f * sp[5 * 33], 64.f * sp[6 * 33], 64.f * sp[7 * 33]);
        o.z = pk4_fp8(64.f * sp[8 * 33], 64.f * sp[9 * 33], 64.f * sp[10 * 33], 64.f * sp[11 * 33]); o.w = pk4_fp8(64.f * sp[12 * 33], 64.f * sp[13 * 33], 64.f * sp[14 * 33], 64.f * sp[15 * 33]);
        __builtin_nontemporal_store(o, (u32x4*)(WT + (size_t)(drow0 + n) * K + k0 + 16 * c)); }
    LDS_WAIT(); asm volatile("" ::: "memory");
}
__device__ __forceinline__ void cvt_job8(const float* W, int K, int N, unsigned char* WT, int il, int item, LAS float* scr, int lane) {
    const int nblk = N / 32, kb = item / nblk, nb = item % nblk, n0 = 32 * nb;
    const int drow0 = il == 0 ? n0 : ((n0 >> 7) * 256 + (n0 & 127) + (il == 2 ? 128 : 0));
    cvt_item8(W, K, N, WT, 128 * kb, n0, drow0, scr, lane);
}
__device__ __forceinline__ void cvt_job(const float* W, int K, int N, bf16* WT, int il, int item, LAS float* scr, int lane) {
    const int nblk = N / 32, kb = item / nblk, nb = item % nblk, n0 = 32 * nb;
    const int drow0 = il == 0 ? n0 : ((n0 >> 7) * 256 + (n0 & 127) + (il == 2 ? 128 : 0));
    cvt_item(W, K, N, WT, 64 * kb, n0, drow0, scr, lane);
}

__device__ __forceinline__ void rms_row_bf16(const float* xrow, const float* gain, bf16* orow, int lane) {
    const f32x4* xr = (const f32x4*)xrow + lane;
    f32x4 v[8]; float s = 0.f;
#pragma unroll
    for (int j = 0; j < 8; ++j) { v[j] = xr[64 * j]; s += (v[j][0] * v[j][0] + v[j][1] * v[j][1]) + (v[j][2] * v[j][2] + v[j][3] * v[j][3]); }
    const float rstd = 1.0f / sqrtf(wave_sum(s) * (1.f / DM) + RMS_EPS);
    const f32x4* gr = (const f32x4*)gain + lane;
    u32x2* o8 = (u32x2*)orow + lane;
#pragma unroll
    for (int j = 0; j < 8; ++j) { const f32x4 g = gr[64 * j]; u32x2 w; w.x = pk2(v[j][0] * rstd * g[0], v[j][1] * rstd * g[1]); w.y = pk2(v[j][2] * rstd * g[2], v[j][3] * rstd * g[3]); o8[64 * j] = w; }
}
__device__ __forceinline__ void rms_row_fp8(const float* xrow, const float* gain, unsigned char* orow, int lane) {
    const f32x4* xr = (const f32x4*)xrow + lane;
    f32x4 v[8]; float s = 0.f;
#pragma unroll
    for (int j = 0; j < 8; ++j) { v[j] = xr[64 * j]; s += (v[j][0] * v[j][0] + v[j][1] * v[j][1]) + (v[j][2] * v[j][2] + v[j][3] * v[j][3]); }
    const float rstd = 1.0f / sqrtf(wave_sum(s) * (1.f / DM) + RMS_EPS);
    const f32x4* gr = (const f32x4*)gain + lane;
    unsigned* o4 = (unsigned*)orow + lane;
#pragma unroll
    for (int j = 0; j < 8; ++j) { const f32x4 g = gr[64 * j]; o4[64 * j] = pk4_fp8(v[j][0] * rstd * g[0], v[j][1] * rstd * g[1], v[j][2] * rstd * g[2], v[j][3] * rstd * g[3]); }
}
__device__ __forceinline__ void rms_row_f32(const float* xrow, const float* gain, float* orow, int lane) {
    const f32x4* xr = (const f32x4*)xrow + lane;
    f32x4 v[8]; float s = 0.f;
#pragma unroll
    for (int j = 0; j < 8; ++j) { v[j] = xr[64 * j]; s += (v[j][0] * v[j][0] + v[j][1] * v[j][1]) + (v[j][2] * v[j][2] + v[j][3] * v[j][3]); }
    const float rstd = 1.0f / sqrtf(wave_sum(s) * (1.f / DM) + RMS_EPS);
    const f32x4* gr = (const f32x4*)gain + lane;
    f32x4* o = (f32x4*)orow + lane;
#pragma unroll
    for (int j = 0; j < 8; ++j) { const f32x4 g = gr[64 * j]; o[64 * j] = v[j] * rstd * g; }
}

__device__ __forceinline__ int t5_bucket(int rel) {
    const int n = rel < 0 ? -rel : rel;
    int b;
    if (n < 8) b = n; else { const int m = (31 - __clz(n * n)) - 6; b = 8 + m; b = b > 15 ? 15 : b; }
    return (rel > 0 ? 16 : 0) + b;
}

constexpr int AA_KROW = 160, AA_VROW = 816;
constexpr int AA_K = 0, AA_V = 384 * AA_KROW, AA_TB = AA_V + 64 * AA_VROW, AA_END = AA_TB + 4 * 288 * 4;
static_assert(AA_END <= RING_BYTES, "attention LDS");
__device__ __forceinline__ void attn_a_unit(int unit, int tid, int wave, int lane, LAS unsigned char* lds, const bf16* QA, const bf16* KA, const bf16* VAT, bf16* AO, const float* t5, const float* sinkp) {
    const int b = unit >> 7, nb = (unit >> 2) & 31, kvh = (unit >> 1) & 1, half = unit & 1;
    const int h4 = wave >> 1, head = kvh * 8 + half * 4 + h4;
    const int r = lane & 15, g = lane >> 4;
    __syncthreads();
    {
        const u32x4 z4 = (u32x4){0u, 0u, 0u, 0u};
#pragma unroll
        for (int i = 0; i < 6; ++i) { const int c = tid + 512 * i, row = c >> 3, part = c & 7; const int kpos = 128 * (nb - 1) + row;
            const u32x4 v = (kpos >= 0 && kpos < SEQ) ? *(const u32x4*)(KA + (size_t)(b * SEQ + kpos) * 128 + kvh * 64 + part * 8) : z4;
            *(LAS u32x4*)(lds + AA_K + row * AA_KROW + part * 16) = v; }
#pragma unroll
        for (int i = 0; i < 7; ++i) { const int c = tid + 512 * i; if (c < 64 * 50) { const int d = c / 50, part = c % 50; const int kpos = 128 * (nb - 1) + 8 * part;
            const u32x4 v = (part < 48 && kpos >= 0 && kpos < SEQ) ? *(const u32x4*)(VAT + ((size_t)b * 128 + kvh * 64 + d) * SEQ + kpos) : z4;
            *(LAS u32x4*)(lds + AA_V + d * AA_VROW + part * 16) = v; } }
        for (int idx = tid; idx < 4 * 288; idx += 512) { const int hh = idx / 288, rel = idx % 288 - 143;
            ((LAS float*)(lds + AA_TB))[idx] = t5[t5_bucket(rel) * 16 + kvh * 8 + half * 4 + hh]; }
    }
    __syncthreads();
    const float sink = sinkp[head];
    const LAS float* tb = (const LAS float*)(lds + AA_TB) + h4 * 288 + 143;
#pragma unroll 1
    for (int qt = 0; qt < 4; ++qt) {
        const int qi0 = (wave & 1) * 64 + qt * 16, q16 = qi0 >> 4;
        const bf16* qp = QA + (size_t)(b * SEQ + nb * 128 + qi0 + r) * 1024 + head * 64 + 8 * g;
        const bf16x8 qf0 = *(const bf16x8*)qp, qf1 = *(const bf16x8*)(qp + 32);
        f32x4 s[18];
        float mx = -1e30f;
        const LAS unsigned char* kbase = lds + AA_K + (16 * q16 + r) * AA_KROW + 16 * g;
#pragma unroll
        for (int tt = 0; tt < 17; ++tt) {
            const int kp0 = 128 * (nb - 1) + 16 * (q16 + tt);
            const bool inr = (kp0 >= 0) && (kp0 < SEQ);
            const bf16x8 kf0 = *(const LAS bf16x8*)(kbase + tt * 16 * AA_KROW), kf1 = *(const LAS bf16x8*)(kbase + tt * 16 * AA_KROW + 64);
            f32x4 a = (f32x4){0.f, 0.f, 0.f, 0.f};
            a = __builtin_amdgcn_mfma_f32_16x16x32_bf16(kf0, qf0, a, 0, 0, 0);
            a = __builtin_amdgcn_mfma_f32_16x16x32_bf16(kf1, qf1, a, 0, 0, 0);
#pragma unroll
            for (int j = 0; j < 4; ++j) {
                const int rel = 16 * tt + 4 * g + j - 128 - r;
                const bool ok = inr && ((tt == 0) ? (rel >= -128) : ((tt == 16) ? (rel <= 128) : true));
                const float v = ok ? a[j] * 0.125f + tb[rel] : -1e30f;
                a[j] = v; mx = fmaxf(mx, v);
            }
            s[tt] = a;
        }
        s[17] = (f32x4){-1e30f, -1e30f, -1e30f, -1e30f};
        mx = fmaxf(mx, __shfl_xor(mx, 16)); mx = fmaxf(mx, __shfl_xor(mx, 32));
        const float m = fmaxf(mx, sink);
        float sum = 0.f;
        unsigned pw[18][2];
#pragma unroll
        for (int tt = 0; tt < 18; ++tt) {
            float p[4];
#pragma unroll
            for (int j = 0; j < 4; ++j) { p[j] = (s[tt][j] > -1e29f) ? __expf(s[tt][j] - m) : 0.f; sum += p[j]; }
            pw[tt][0] = pk2(p[0], p[1]); pw[tt][1] = pk2(p[2], p[3]);
        }
        sum += __shfl_xor(sum, 16); sum += __shfl_xor(sum, 32);
        const float inv = 1.0f / (sum + __expf(sink - m));
        f32x4 o[4];
#pragma unroll
        for (int dt = 0; dt < 4; ++dt) o[dt] = (f32x4){0.f, 0.f, 0.f, 0.f};
        const LAS unsigned char* vbase = lds + AA_V + r * AA_VROW + 2 * (16 * q16 + 4 * g);
#pragma unroll
        for (int pr = 0; pr < 9; ++pr) {
            union { bf16x8 v; unsigned u[4]; } pf; pf.u[0] = pw[2 * pr][0]; pf.u[1] = pw[2 * pr][1]; pf.u[2] = pw[2 * pr + 1][0]; pf.u[3] = pw[2 * pr + 1][1];
#pragma unroll
            for (int dt = 0; dt < 4; ++dt) {
                const LAS unsigned char* vp = vbase + dt * 16 * AA_VROW + 64 * pr;
                union { bf16x8 v; u32x2 hh[2]; } vf; vf.hh[0] = *(const LAS u32x2*)vp; vf.hh[1] = *(const LAS u32x2*)(vp + 32);
                o[dt] = __builtin_amdgcn_mfma_f32_16x16x32_bf16(vf.v, pf.v, o[dt], 0, 0, 0);
            }
        }
        unsigned char* op = (unsigned char*)AO + (size_t)(b * SEQ + nb * 128 + qi0 + r) * DM + head * 64 + 4 * g;
#pragma unroll
        for (int dt = 0; dt < 4; ++dt) *(unsigned*)(op + 16 * dt) = pk4_fp8(o[dt][0] * inv, o[dt][1] * inv, o[dt][2] * inv, o[dt][3] * inv);
    }
}

constexpr int AB_K = 0, AB_VROW = 1168, AB_V = 576 * 128, AB_T = AB_V + 64 * AB_VROW, AB_END = AB_T + 2048;
static_assert(AB_END <= MISC_OFF, "attention B LDS");
__device__ __forceinline__ void attn_b_unit(int unit, int tid, int wave, int lane, LAS unsigned char* lds, const bf16* QN, const bf16* KN, const bf16* VNT, bf16* AO, const float* rpb) {
    const int b = unit >> 9, rw0 = ((unit >> 4) & 31) * 2, h = unit & 15;
    const int rs0 = rw0 - 4 < 0 ? 0 : (rw0 - 4 > 56 ? 56 : rw0 - 4);
    const int nkeys = (64 - rs0 < 9 ? 64 - rs0 : 9) * 64;
    __syncthreads();
    {
        const u32x4 z4 = (u32x4){0u, 0u, 0u, 0u};
#pragma unroll
        for (int i = 0; i < 9; ++i) { const int c = tid + 512 * i, key = c >> 3, ch = c & 7;
            const u32x4 v = (key < nkeys) ? *(const u32x4*)(KN + (size_t)(b * SEQ + rs0 * 64 + key) * 1024 + h * 64 + ch * 8) : z4;
            *(LAS u32x4*)(lds + AB_K + key * 128 + ((ch ^ (key & 7)) * 16)) = v; }
#pragma unroll
        for (int i = 0; i < 9; ++i) { const int c = tid + 512 * i, d = c / 72, part = c % 72;
            const u32x4 v = (part * 8 < nkeys) ? *(const u32x4*)(VNT + ((size_t)b * 1024 + h * 64 + d) * SEQ + rs0 * 64 + part * 8) : z4;
            *(LAS u32x4*)(lds + AB_V + d * AB_VROW + part * 16) = v; }
        if (tid < 465) ((LAS float*)(lds + AB_T))[tid] = rpb[(size_t)h * 465 + tid];
    }
    __syncthreads();
    const int rw = rw0 + (wave >> 2), jq = wave & 3;
    const int r = lane & 15, g = lane >> 4;
    const int cb = (jq == 0) ? 0 : (jq == 1 ? 8 : (jq == 2 ? 24 : 32));
    const int rs = rw - 4 < 0 ? 0 : (rw - 4 > 56 ? 56 : rw - 4);
    const int c = 16 * jq + r;
    const int cs = c - 8 < 0 ? 0 : (c - 8 > 48 ? 48 : c - 8);
    const bf16* qp = QN + (size_t)(b * SEQ + rw * 64 + c) * 1024 + h * 64 + 8 * g;
    const bf16x8 qf0 = *(const bf16x8*)qp, qf1 = *(const bf16x8*)(qp + 32);
    const LAS float* rpt = (const LAS float*)(lds + AB_T);
    f32x4 s[16];
    float mx = -1e30f;
    const int kl0 = (rs - rs0) * 64 + cb + r;
#pragma unroll
    for (int kt = 0; kt < 16; ++kt) { const int kr = kt >> 1, ch = kt & 1; const int kl = kl0 + kr * 64 + 16 * ch; const int sw = kl & 7;
        const LAS unsigned char* kp = lds + AB_K + kl * 128;
        const bf16x8 kf0 = *(const LAS bf16x8*)(kp + ((g ^ sw) * 16)), kf1 = *(const LAS bf16x8*)(kp + (((g + 4) ^ sw) * 16));
        f32x4 a = (f32x4){0.f, 0.f, 0.f, 0.f};
        a = __builtin_amdgcn_mfma_f32_16x16x32_bf16(kf0, qf0, a, 0, 0, 0);
        a = __builtin_amdgcn_mfma_f32_16x16x32_bf16(kf1, qf1, a, 0, 0, 0);
        const int roff = (rs + kr) - rw + 7;
#pragma unroll
        for (int j = 0; j < 4; ++j) {
            const int kc = cb + 16 * ch + 4 * g + j;
            const bool ok = (kc >= cs) && (kc < cs + 16);
            int coff = kc - c + 15; coff = coff < 0 ? 0 : (coff > 30 ? 30 : coff);
            const float v = ok ? a[j] * 0.125f + rpt[roff * 31 + coff] : -1e30f;
            a[j] = v; mx = fmaxf(mx, v);
        }
        s[kt] = a; }
    mx = fmaxf(mx, __shfl_xor(mx, 16)); mx = fmaxf(mx, __shfl_xor(mx, 32));
    float sum = 0.f;
    unsigned pw[16][2];
#pragma unroll
    for (int kt = 0; kt < 16; ++kt) {
        float p[4];
#pragma unroll
        for (int j = 0; j < 4; ++j) { p[j] = (s[kt][j] > -1e29f) ? __expf(s[kt][j] - mx) : 0.f; sum += p[j]; }
        pw[kt][0] = pk2(p[0], p[1]); pw[kt][1] = pk2(p[2], p[3]);
    }
    sum += __shfl_xor(sum, 16); sum += __shfl_xor(sum, 32);
    const float inv = 1.0f / sum;
    f32x4 o[4];
#pragma unroll
    for (int dt = 0; dt < 4; ++dt) o[dt] = (f32x4){0.f, 0.f, 0.f, 0.f};
    const LAS unsigned char* vbase = lds + AB_V + r * AB_VROW + 2 * ((rs - rs0) * 64 + cb + 4 * g);
#pragma unroll
    for (int kr = 0; kr < 8; ++kr) {
        union { bf16x8 v; unsigned u[4]; } pf; pf.u[0] = pw[2 * kr][0]; pf.u[1] = pw[2 * kr][1]; pf.u[2] = pw[2 * kr + 1][0]; pf.u[3] = pw[2 * kr + 1][1];
#pragma unroll
        for (int dt = 0; dt < 4; ++dt) { const LAS unsigned char* vp = vbase + dt * 16 * AB_VROW + kr * 128;
            union { bf16x8 v; u32x2 hh[2]; } vf; vf.hh[0] = *(const LAS u32x2*)vp; vf.hh[1] = *(const LAS u32x2*)(vp + 32);
            o[dt] = __builtin_amdgcn_mfma_f32_16x16x32_bf16(vf.v, pf.v, o[dt], 0, 0, 0); }
    }
    unsigned char* op = (unsigned char*)AO + (size_t)(b * SEQ + rw * 64 + c) * DM + 1024 + h * 64 + 4 * g;
#pragma unroll
    for (int dt = 0; dt < 4; ++dt) *(unsigned*)(op + 16 * dt) = pk4_fp8(o[dt][0] * inv, o[dt][1] * inv, o[dt][2] * inv, o[dt][3] * inv);
}

__device__ __forceinline__ void hy_hidden1(int item, int lane, const float* fw1, const float* fb1, const float* fr, float* H1) {
    const int t = (item >> 3) * 64 + lane, j0 = (item & 7) * 8;
    float zv[33];
    zv[0] = (float)t * (1.0f / 4095.0f);
    const float w = (6.283185307179586f / 4096.0f) * (float)t;
#pragma unroll
    for (int k = 0; k < 16; ++k) { const float f = 1e-4f + (float)k * ((15.0f - 1e-4f) / 15.0f); const float a = f * w; zv[1 + k] = cosf(a); zv[17 + k] = -sinf(a); }
    float o[8];
#pragma unroll
    for (int jj = 0; jj < 8; ++jj) { const int j = j0 + jj; float sacc = fb1[j];
#pragma unroll
        for (int m = 0; m < 33; ++m) sacc += zv[m] * fw1[m * 64 + j];
        o[jj] = sinf(fr[j] * sacc); }
    f32x4* dst = (f32x4*)(H1 + (size_t)t * 64 + j0); dst[0] = (f32x4){o[0], o[1], o[2], o[3]}; dst[1] = (f32x4){o[4], o[5], o[6], o[7]};
}
__device__ __forceinline__ void hy_hidden2(int item, int lane, const float* fw2, const float* fb2, const float* fr, const float* H1, bf16* AF) {
    const int t = (item >> 3) * 64 + lane, j0 = (item & 7) * 8;
    float h1[64];
    const f32x4* src = (const f32x4*)(H1 + (size_t)t * 64);
#pragma unroll
    for (int q = 0; q < 16; ++q) { const f32x4 v = src[q]; h1[4 * q] = v[0]; h1[4 * q + 1] = v[1]; h1[4 * q + 2] = v[2]; h1[4 * q + 3] = v[3]; }
    float o[8];
#pragma unroll
    for (int jj = 0; jj < 8; ++jj) { const int j = j0 + jj; float sacc = fb2[j];
#pragma unroll
        for (int m = 0; m < 64; ++m) sacc += h1[m] * fw2[m * 64 + j];
        o[jj] = sinf(fr[j] * sacc); }
    bf16* orow = AF + (size_t)t * 256;
    u32x4 w; w.x = pk2(o[0], o[1]); w.y = pk2(o[2], o[3]); w.z = pk2(o[4], o[5]); w.w = pk2(o[6], o[7]);
    *(u32x4*)(orow + j0) = w;
    const u32x4 z4 = (u32x4){0u, 0u, 0u, 0u};
#pragma unroll
    for (int i = 0; i < 3; ++i) *(u32x4*)(orow + 64 + 8 * ((item & 7) * 3 + i)) = z4;
}

constexpr int CV_ZROW = 160;
constexpr int CV_HW = 4160;
constexpr int CV_F = 2 * 64 * CV_ZROW;
constexpr int CV_ZERO = CV_F + 2 * CV_HW * 2;
constexpr int CV_PAIR = CV_ZERO + 128;
static_assert(4 * CV_PAIR <= MISC_OFF, "conv LDS");
__device__ __forceinline__ u32x4 conv_fchunk(const bf16* fw, const bf16* bw, int Q) {
    u32x4 o = (u32x4){0u, 0u, 0u, 0u};
    if (Q < 512) {
        const u32x4 r1 = *(const u32x4*)(fw + 4088 - 8 * Q);
        const unsigned n0 = (Q > 0) ? *(const unsigned*)(fw + 4096 - 8 * Q) : 0u;
        o.x = (n0 & 0xffffu) | (r1.w & 0xffff0000u); o.y = (r1.w & 0xffffu) | (r1.z & 0xffff0000u); o.z = (r1.z & 0xffffu) | (r1.y & 0xffff0000u); o.w = (r1.y & 0xffffu) | (r1.x & 0xffff0000u);
    } else if (Q < 1024) {
        o = *(const u32x4*)(bw + 8 * (Q - 512));
        if (Q == 512) { const unsigned c0 = f2bf(bf2f(fw[0]) + bflo(o.x)); o.x = (o.x & 0xffff0000u) | c0; }
    }
    return o;
}
__device__ __forceinline__ void hyena_conv_unit(int unit, int wave, int lane, LAS unsigned char* lds, const bf16* PROJT, const bf16* FILT, const float* cw, const float* cbias, const float* fbias, bf16* ZFT) {
    const int pair = wave >> 1, b = wave & 1, c = unit * 4 + pair;
    LAS unsigned char* pb = lds + pair * CV_PAIR;
    LAS unsigned char* zb = pb + b * (64 * CV_ZROW);
    LAS unsigned char* fc = pb + CV_F;
    LAS unsigned char* zero_p = pb + CV_ZERO;
    const int r = lane & 15, g = lane >> 4;
    if (b == 0 && lane < 32) ((LAS unsigned*)zero_p)[lane] = 0u;
    {
        const int f = 4096 + c;
        const float w0 = cw[f], w1 = cw[6144 + f], w2 = cw[2 * 6144 + f], cb = cbias[f];
        const bf16* src = PROJT + (size_t)f * NTOK + b * SEQ + lane * 64;
        float prev = (lane == 0) ? 0.f : bf2f(src[-1]);
        const float last = (lane == 63) ? 0.f : bf2f(src[64]);
#pragma unroll
        for (int i = 0; i < 8; ++i) {
            const u32x4 raw = *(const u32x4*)(src + 8 * i);
            const u32x4 nxt = (i < 7) ? *(const u32x4*)(src + 8 * i + 8) : raw;
            float v[10]; v[0] = prev;
            v[1] = bflo(raw.x); v[2] = bfhi(raw.x); v[3] = bflo(raw.y); v[4] = bfhi(raw.y); v[5] = bflo(raw.z); v[6] = bfhi(raw.z); v[7] = bflo(raw.w); v[8] = bfhi(raw.w);
            v[9] = (i < 7) ? bflo(nxt.x) : last;
            float o[8];
#pragma unroll
            for (int k = 0; k < 8; ++k) o[k] = w0 * v[k] + w1 * v[k + 1] + w2 * v[k + 2] + cb;
            u32x4 w; w.x = pk2(o[0], o[1]); w.y = pk2(o[2], o[3]); w.z = pk2(o[4], o[5]); w.w = pk2(o[6], o[7]);
            *(LAS u32x4*)(zb + lane * CV_ZROW + 16 * i) = w;
            prev = v[8];
        }
    }
    const int a_lane = (r & 1) * (CV_HW * 2) + 2 * (8 * g - r - (r & 1));
#pragma unroll 1
    for (int o = 0; o < 2; ++o) {
        const bf16* fw = FILT + ((size_t)(o * 2048 + c) * 2) * 4096; const bf16* bw = fw + 4096;
        f32x4 acc[4][4];
#pragma unroll
        for (int m = 0; m < 4; ++m)
#pragma unroll
            for (int n = 0; n < 4; ++n) acc[m][n] = (f32x4){0.f, 0.f, 0.f, 0.f};
        bf16x8 O2, O3, NC[4];
        union FragW { bf16x8 v; unsigned w[4]; };
#define CV_STAGE(QB) do { __syncthreads(); \
            _Pragma("unroll 1") for (int q = b * 64 + lane; q < CV_HW / 8; q += 128) { const u32x4 c0 = conv_fchunk(fw, bw, (QB) + q), c1 = conv_fchunk(fw, bw, (QB) + q + 1); \
                u32x4 s1; s1.x = __builtin_amdgcn_alignbit(c0.y, c0.x, 16); s1.y = __builtin_amdgcn_alignbit(c0.z, c0.y, 16); s1.z = __builtin_amdgcn_alignbit(c0.w, c0.z, 16); s1.w = __builtin_amdgcn_alignbit(c1.x, c0.w, 16); \
                *(LAS u32x4*)(fc + 16 * q) = c0; *(LAS u32x4*)(fc + CV_HW * 2 + 16 * q) = s1; } \
            __syncthreads(); } while (0)
#define CV_LOADA(dst, u, WB) do { const volatile LAS unsigned* _p = (const volatile LAS unsigned*)(fc + a_lane + 2 * (4096 - (WB) - 16 * (u))); FragW _f; _f.w[0] = _p[0]; _f.w[1] = _p[1]; _f.w[2] = _p[2]; _f.w[3] = _p[3]; dst = _f.v; } while (0)
#define CV_SEG(NLO, NHI, D0, D1, WB) _Pragma("unroll 1") for (int d = (D0); d <= (D1); ++d) { \
            bf16x8 Bf[4][2]; \
            _Pragma("unroll") for (int n = (NLO); n <= (NHI); ++n) { const int row = 16 * n + r - d; const bool ok = (unsigned)row < 64u; \
                const LAS unsigned char* bp = ok ? (zb + row * CV_ZROW + 16 * g) : zero_p; Bf[n][1] = *(const LAS bf16x8*)(bp + 64); Bf[n][0] = *(const LAS bf16x8*)bp; } \
            CV_LOADA(NC[0], 4 * d, WB); CV_LOADA(NC[1], 4 * d + 1, WB); CV_LOADA(NC[2], 4 * d + 2, WB); CV_LOADA(NC[3], 4 * d + 3, WB); \
            __builtin_amdgcn_s_setprio(1); \
            _Pragma("unroll") for (int n = (NLO); n <= (NHI); ++n) { acc[0][n] = __builtin_amdgcn_mfma_f32_16x16x32_bf16(O2, Bf[n][1], acc[0][n], 0, 0, 0); acc[1][n] = __builtin_amdgcn_mfma_f32_16x16x32_bf16(O3, Bf[n][1], acc[1][n], 0, 0, 0); } \
            _Pragma("unroll") for (int n = (NLO); n <= (NHI); ++n) { acc[2][n] = __builtin_amdgcn_mfma_f32_16x16x32_bf16(NC[0], Bf[n][1], acc[2][n], 0, 0, 0); acc[3][n] = __builtin_amdgcn_mfma_f32_16x16x32_bf16(NC[1], Bf[n][1], acc[3][n], 0, 0, 0); } \
            _Pragma("unroll") for (int m = 0; m < 4; ++m) _Pragma("unroll") for (int n = (NLO); n <= (NHI); ++n) acc[m][n] = __builtin_amdgcn_mfma_f32_16x16x32_bf16(NC[m], Bf[n][0], acc[m][n], 0, 0, 0); \
            __builtin_amdgcn_s_setprio(0); O2 = NC[2]; O3 = NC[3]; }
        CV_STAGE(512);
        CV_LOADA(O2, 4 * (-64) + 2, 4096); CV_LOADA(O3, 4 * (-64) + 3, 4096);
        CV_SEG(0, 0, -63, -48, 4096)
        CV_SEG(0, 1, -47, -32, 4096)
        CV_SEG(0, 2, -31, -16, 4096)
        CV_SEG(0, 3, -15, -1, 4096)
        CV_STAGE(0);
        CV_SEG(0, 3, 0, 15, 0)
        CV_SEG(1, 3, 16, 31, 0)
        CV_SEG(2, 3, 32, 47, 0)
        CV_SEG(3, 3, 48, 63, 0)
#undef CV_SEG
#undef CV_LOADA
#undef CV_STAGE
        {
            const int fx = (o == 0) ? c : 2048 + c;
            const float w0 = cw[fx], w1 = cw[6144 + fx], w2 = cw[2 * 6144 + fx], cbx = cbias[fx], fb = fbias[o * 2048 + c];
            const bf16* xs = PROJT + (size_t)fx * NTOK + b * SEQ;
#pragma unroll
            for (int n = 0; n < 4; ++n)
#pragma unroll
                for (int m = 0; m < 4; ++m) {
                    const int t = 64 * (16 * n + r) + 16 * m + 4 * g;
                    const u32x2 xr = *(const u32x2*)(xs + t);
                    float xv[6]; xv[0] = (t > 0) ? bf2f(xs[t - 1]) : 0.f; xv[1] = bflo(xr.x); xv[2] = bfhi(xr.x); xv[3] = bflo(xr.y); xv[4] = bfhi(xr.y); xv[5] = (t + 4 < SEQ) ? bf2f(xs[t + 4]) : 0.f;
                    LAS u32x2* zp = (LAS u32x2*)(zb + (16 * n + r) * CV_ZROW + 2 * (16 * m + 4 * g));
                    const u32x2 zr = *zp; float zo[4]; zo[0] = bflo(zr.x); zo[1] = bfhi(zr.x); zo[2] = bflo(zr.y); zo[3] = bfhi(zr.y);
                    float v[4];
#pragma unroll
                    for (int j = 0; j < 4; ++j) { const float gate = w0 * xv[j] + w1 * xv[j + 1] + w2 * xv[j + 2] + cbx; v[j] = gate * (acc[m][n][j] + zo[j] * fb); }
                    u32x2 w; w.x = pk2(v[0], v[1]); w.y = pk2(v[2], v[3]); *zp = w;
                }
        }
        LDS_WAIT(); asm volatile("" ::: "memory");
    }
    {
        bf16* dst = ZFT + (size_t)c * NTOK + b * SEQ + lane * 64;
#pragma unroll
        for (int i = 0; i < 8; ++i) *(u32x4*)(dst + 8 * i) = *(const LAS u32x4*)(zb + lane * CV_ZROW + 16 * i);
    }
    LDS_WAIT(); asm volatile("" ::: "memory");
}

__device__ __forceinline__ void transpose_tile(int tile, int lane, LAS unsigned short* tl, const bf16* ZFT, bf16* ZF) {
    const int c0 = (tile & 31) * 64, t0 = (tile >> 5) * 64;
    const bf16* src = ZFT + (size_t)(c0 + lane) * NTOK + t0;
#pragma unroll
    for (int i = 0; i < 8; ++i) { const u32x4 v = *(const u32x4*)(src + 8 * i); LAS unsigned* p = (LAS unsigned*)(tl + lane * 66 + 8 * i); p[0] = v.x; p[1] = v.y; p[2] = v.z; p[3] = v.w; }
    LDS_WAIT(); asm volatile("" ::: "memory");
    const int cg = lane & 7;
#pragma unroll
    for (int j = 0; j < 8; ++j) { const int tt = (lane >> 3) + 8 * j; const LAS unsigned short* p = tl + (8 * cg) * 66 + tt;
        u32x4 w; w.x = (unsigned)p[0] | ((unsigned)p[66] << 16); w.y = (unsigned)p[2 * 66] | ((unsigned)p[3 * 66] << 16); w.z = (unsigned)p[4 * 66] | ((unsigned)p[5 * 66] << 16); w.w = (unsigned)p[6 * 66] | ((unsigned)p[7 * 66] << 16);
        *(u32x4*)(ZF + (size_t)(t0 + tt) * DM + c0 + 8 * cg) = w; }
    LDS_WAIT(); asm volatile("" ::: "memory");
}


__device__ __forceinline__ void router_token(int m, int lane, const float* H, const float* gain, const float* wr, bf16* HN, unsigned* ctl, LAS unsigned* lhist) {
    const f32x4* xr = (const f32x4*)(H + (size_t)m * DM) + lane;
    f32x4 v[8]; float ss = 0.f;
#pragma unroll
    for (int j = 0; j < 8; ++j) { v[j] = xr[64 * j]; ss += (v[j][0] * v[j][0] + v[j][1] * v[j][1]) + (v[j][2] * v[j][2] + v[j][3] * v[j][3]); }
    const float rstd = 1.0f / sqrtf(wave_sum(ss) * (1.f / DM) + RMS_EPS);
    const f32x4* gr = (const f32x4*)gain + lane;
    unsigned* o8 = (unsigned*)((unsigned char*)HN + (size_t)m * DM) + lane;
    float lg[8];
#pragma unroll
    for (int e = 0; e < 8; ++e) lg[e] = 0.f;
#pragma unroll
    for (int j = 0; j < 8; ++j) { const f32x4 g = gr[64 * j]; f32x4 hn = v[j] * rstd * g;
        o8[64 * j] = pk4_fp8(hn[0], hn[1], hn[2], hn[3]);
        const f32x4* wp = (const f32x4*)(wr + (size_t)(4 * (lane + 64 * j)) * 8);
#pragma unroll
        for (int i = 0; i < 4; ++i) { const f32x4 wa = wp[2 * i], wb = wp[2 * i + 1];
            lg[0] += hn[i] * wa[0]; lg[1] += hn[i] * wa[1]; lg[2] += hn[i] * wa[2]; lg[3] += hn[i] * wa[3];
            lg[4] += hn[i] * wb[0]; lg[5] += hn[i] * wb[1]; lg[6] += hn[i] * wb[2]; lg[7] += hn[i] * wb[3]; } }
#pragma unroll
    for (int e = 0; e < 8; ++e) lg[e] = wave_sum(lg[e]);
    int i1 = 0; float v1 = lg[0];
#pragma unroll
    for (int e = 1; e < 8; ++e) if (lg[e] > v1) { v1 = lg[e]; i1 = e; }
    int i2 = -1; float v2 = -3.0e38f;
#pragma unroll
    for (int e = 0; e < 8; ++e) if (e != i1 && lg[e] > v2) { v2 = lg[e]; i2 = e; }
    const float g2 = 1.0f / (1.0f + __expf(v1 - v2)), g1 = 1.0f - g2;
    if (lane == 0) {
        ctl[CW_TOKE + 2 * m] = (unsigned)i1; ctl[CW_TOKE + 2 * m + 1] = (unsigned)i2;
        ctl[CW_TOKG + 2 * m] = __builtin_bit_cast(unsigned, g1); ctl[CW_TOKG + 2 * m + 1] = __builtin_bit_cast(unsigned, g2);
        atomicAdd((unsigned*)&lhist[i1], 1u); atomicAdd((unsigned*)&lhist[i2], 1u);
    }
}

__device__ __forceinline__ int fresh_tid() { int t = threadIdx.x; asm volatile("" : "+v"(t)); return t; }

__global__ void __launch_bounds__(NTHR, 2) fwd_kernel(Args args) {
    extern __shared__ __attribute__((aligned(16))) unsigned char lds_raw[];
    LAS unsigned char* lds = (LAS unsigned char*)lds_raw;
    volatile LAS unsigned* MISC = (volatile LAS unsigned*)(lds + MISC_OFF);
    const int tid = threadIdx.x, lane = tid & 63, wave = __builtin_amdgcn_readfirstlane(tid >> 6);
    const int G = gridDim.x, bid = blockIdx.x;
    const int gw = bid * NWAVES + wave, NGW = G * NWAVES;
    unsigned char* ws = args.ws;
    unsigned* ctl = (unsigned*)(ws + WS_CTL);
    for (int u = tid; u < (LDS_BYTES - MISC_OFF) / 4; u += NTHR) ((LAS unsigned*)(lds + MISC_OFF))[u] = 0u;
    __syncthreads();
#if MK_ONE_LAUNCH
    XcdBarrier bar = xcd_barrier_post(ctl + CW_BAR, MISC + 8);
#define GRID_BAR() xcd_barrier(bar)
#else
#define GRID_BAR() do { } while (0)
#endif
    const int lo = args.ph_lo, hi = args.ph_hi;
#define IN(k) (lo <= (k) && (k) < hi && ((k) <= LAST_PHASE || (k) == 20))
#define SEAM(k) do { if (IN(k) && IN((k) + 1)) GRID_BAR(); } while (0)

    const float* x = args.in[I_X];
    float* H = (float*)(ws + WS_H);
    bf16* HN = (bf16*)(ws + WS_HN);
    bf16* W_QK = (bf16*)(ws + WS_W_QK); bf16* W_V = (bf16*)(ws + WS_W_V); bf16* W_AO = (bf16*)(ws + WS_W_AO);
    bf16* W_GU = (bf16*)(ws + WS_W_GU); bf16* W_FD = (bf16*)(ws + WS_W_FD); bf16* W_PG = (bf16*)(ws + WS_W_PG); bf16* W_PP = (bf16*)(ws + WS_W_PP);
    bf16* W_HI = (bf16*)(ws + WS_W_HI); bf16* W_HO = (bf16*)(ws + WS_W_HO); bf16* W_EGU = (bf16*)(ws + WS_W_EGU); bf16* W_ED = (bf16*)(ws + WS_W_ED);
    bf16* PP = (bf16*)(ws + WS_PP); bf16* PB = (bf16*)(ws + WS_PB);
    bf16* QA = (bf16*)(ws + WS_QA); bf16* QN = (bf16*)(ws + WS_QN); bf16* KN = (bf16*)(ws + WS_KN); bf16* KA = (bf16*)(ws + WS_KA);
    bf16* FILT = (bf16*)(ws + WS_FILT); bf16* AF = (bf16*)(ws + WS_AF); bf16* BF = (bf16*)(ws + WS_BF);
    bf16* PROJT = (bf16*)(ws + WS_PROJT); bf16* ZFT = (bf16*)(ws + WS_ZFT); bf16* ZF = (bf16*)(ws + WS_ZF);
    bf16* XS = (bf16*)(ws + WS_XS); bf16* HMID = (bf16*)(ws + WS_HMID); float* Y = (float*)(ws + WS_Y);
    bf16* VAT = (bf16*)(ws + WS_VAT); bf16* VNT = (bf16*)(ws + WS_VNT); bf16* AO = (bf16*)(ws + WS_AO); bf16* MID = (bf16*)(ws + WS_MID);

    if (IN(0)) { const int tid = fresh_tid(), lane = tid & 63; (void)tid; (void)lane;
        LAS float* scr = (LAS float*)(lds + wave * 16384);
        constexpr int IT_AIN = (DM / 64) * (4352 / 32), IT_SQ = (DM / 64) * (DM / 32), IT_FGU = (DM / 64) * (DFF / 32), IT_FD = (DFF / 64) * (DM / 32);
        constexpr int IT_PPJ = (256 / 64) * (DM / 32), IT_HI = (DM / 64) * (6144 / 32), IT_EGU = (DM / 64) * (DFFE / 32), IT_ED = (DFFE / 64) * (DM / 32);
        constexpr int NIT = 2 * IT_FGU + IT_FD + IT_SQ + 2 * IT_PPJ + IT_HI + IT_SQ;
        for (int it = gw; it < NIT; it += NGW) {
            int r = it;
            if (r < IT_FGU) { cvt_job(args.in[I_W_FG], DM, DFF, W_GU, 1, r, scr, lane); continue; } r -= IT_FGU;
            if (r < IT_FGU) { cvt_job(args.in[I_W_FU], DM, DFF, W_GU, 2, r, scr, lane); continue; } r -= IT_FGU;
            if (r < IT_FD) { cvt_job(args.in[I_W_FD], DFF, DM, W_FD, 0, r, scr, lane); continue; } r -= IT_FD;
            if (r < IT_SQ) { cvt_job(args.in[I_W_PG], DM, DM, W_PG, 0, r, scr, lane); continue; } r -= IT_SQ;
            if (r < 2 * IT_PPJ) { const int l = r / IT_PPJ; cvt_job(args.in[I_W_PP] + (size_t)l * 256 * DM, 256, DM, W_PP + (size_t)l * DM * 256, 0, r % IT_PPJ, scr, lane); continue; } r -= 2 * IT_PPJ;
            if (r < IT_HI) { cvt_job(args.in[I_W_HI], DM, 6144, W_HI, 0, r, scr, lane); continue; } r -= IT_HI;
            cvt_job(args.in[I_W_HO], DM, DM, W_HO, 0, r, scr, lane);
        }
        __syncthreads();
        {
            LAS float* scr8 = (LAS float*)(lds + wave * 16896);
            constexpr int IT8_EGU = (DM / 128) * (DFFE / 32), IT8_ED = (DFFE / 128) * (DM / 32);
            unsigned char* W8GU = (unsigned char*)W_EGU; unsigned char* W8D = (unsigned char*)W_ED;
            constexpr int IT8_PG = (DM / 128) * (DM / 32), IT8_AIN = (DM / 128) * (4352 / 32), IT8_X = 16 * IT8_EGU + 8 * IT8_ED;
            for (int it = gw; it < IT8_X + 2 * IT8_PG + IT8_AIN; it += NGW) {
                int r = it;
                if (r >= IT8_X) { r -= IT8_X;
                    if (r < IT8_PG) { cvt_job8(args.in[I_W_PG] + (size_t)DM * DM, DM, DM, (unsigned char*)(ws + WS_PG8), 0, r, scr8, lane); continue; } r -= IT8_PG;
                    if (r < IT8_PG) { cvt_job8(args.in[I_W_AOUT], DM, DM, (unsigned char*)W_AO, 0, r, scr8, lane); continue; } r -= IT8_PG;
                    { const int nblk = 4352 / 32, kb = r / nblk, n0 = 32 * (r % nblk); unsigned char* dst; int drow0;
                      if (n0 < 1024) { dst = (unsigned char*)W_QK; drow0 = n0; } else if (n0 < 1152) { dst = (unsigned char*)W_V; drow0 = n0 - 1024; }
                      else if (n0 < 1280) { dst = (unsigned char*)W_V; drow0 = n0 - 1152 + 128; } else if (n0 < 2304) { dst = (unsigned char*)W_QK; drow0 = n0 - 1280 + 1024; }
                      else if (n0 < 3328) { dst = (unsigned char*)W_QK; drow0 = n0 - 2304 + 2048; } else { dst = (unsigned char*)W_V; drow0 = n0 - 3328 + 256; }
                      cvt_item8(args.in[I_W_AIN], DM, 4352, dst, 128 * kb, n0, drow0, scr8, lane); }
                    continue; }
                if (r < 16 * IT8_EGU) { const int j = r / IT8_EGU, e = j >> 1, up = j & 1;
                    cvt_job8(args.in[up ? I_W_EU : I_W_EG] + (size_t)e * DM * DFFE, DM, DFFE, W8GU + (size_t)e * 2 * DFFE * DM, up ? 2 : 1, r % IT8_EGU, scr8, lane); continue; }
                r -= 16 * IT8_EGU;
                { const int e = r / IT8_ED; cvt_job8(args.in[I_W_ED] + (size_t)e * DFFE * DM, DFFE, DM, W8D + (size_t)e * DM * DFFE, 0, r % IT8_ED, scr8, lane); }
            }
            __syncthreads();
        }
        { const f32x4* ps = (const f32x4*)args.in[I_P]; u32x2* pd = (u32x2*)PB; const int n4 = 2 * NTOK * 256 / 4;
          for (int i = gw * 64 + lane; i < n4; i += NGW * 64) { const f32x4 v = ps[i]; u32x2 w; w.x = pk2(v[0], v[1]); w.y = pk2(v[2], v[3]); pd[i] = w; } }
        { const int h1off = NGW >= 512 ? NGW - 512 : 0;
          for (int it = gw - h1off; it < 512; it += NGW) if (it >= 0) hy_hidden1(it, lane, args.in[I_W_F1], args.in[I_B_F1], args.in[I_FREQ], (float*)(ws + WS_H1)); }
        for (int it = gw; it < 256; it += NGW) cvt_item(args.in[I_W_F3], 256, 8192, BF, 0, 32 * it, 32 * it, scr, lane);
        { const u32x4 z4 = (u32x4){0u, 0u, 0u, 0u};
          for (int i = gw * 64 + lane; i < 8192 * 24; i += NGW * 64) { const int row = i / 24, ch = i % 24; *(u32x4*)(BF + (size_t)row * 256 + 64 + 8 * ch) = z4; } }
        for (int m = gw; m < NTOK; m += NGW) rms_row_fp8(x + (size_t)m * DM, args.in[I_LN_MIX], (unsigned char*)HN + (size_t)m * DM, lane);
    }
    SEAM(0);

    if (IN(1)) { const int tid = fresh_tid(), lane = tid & 63; (void)tid; (void)lane;
        for (int it = NGW - 1 - gw; it < 512; it += NGW) hy_hidden2(it, lane, args.in[I_W_F2], args.in[I_B_F2], args.in[I_FREQ], (const float*)(ws + WS_H1), AF);
        { pg8::Gemm g{HN, W_QK, NTOK, 3072, DM / 2, DM / 2}; pg8::StaticOrder S; S.init(NTOK, 3072, G, bid);
          pg8::EpiBf16T<true> E{QA, 1024, 1024, (size_t)NTOK * 1024, 1.0f / 64.0f};
          pg8::gemm_phase(lds, g, S, E); }
        { pg8::Gemm g{HN, W_V, NTOK, 1280, DM / 2, DM / 2}; pg8::StaticOrder S; S.init(NTOK, 1280, G, (bid + 128) % G);
          pg8::EpiVT<true> E{KA, VAT, VNT, 1.0f / 64.0f};
          pg8::gemm_phase(lds, g, S, E); }
        const int Gs = G > 64 ? G - 32 : G, cs = G > 64 ? bid - 32 : bid;
        if (cs >= 0)
#pragma unroll 1
        for (int l = 0; l < 2; ++l) {
          pg8::Gemm g{PB + (size_t)l * NTOK * 256, W_PP + (size_t)l * DM * 256, NTOK, DM, 256, 256}; pg8::StaticOrder S; S.init(NTOK, DM, Gs, cs);
          pg8::EpiBf16 E{PP + (size_t)l * NTOK * DM, DM, 0, 0, 1.0f};
          pg8::gemm_phase(lds, g, S, E); }
    }
    SEAM(1);

    if (IN(2)) { const int tid = fresh_tid(), lane = tid & 63; (void)tid; (void)lane;
        { pg8::Gemm g{AF, BF, 4096, 8192, 256, 256}; pg8::StaticOrder S; S.init(4096, 8192, G, bid);
          pg8::EpiFilt E{FILT};
          pg8::gemm_phase(lds, g, S, E); }
        for (int u = bid; u < 256; u += G) attn_a_unit(u, tid, wave, lane, lds, QA, KA, VAT, AO, args.in[I_T5], args.in[I_SINK]);
        for (int u = bid; u < 1024; u += G) attn_b_unit(u, tid, wave, lane, lds, QN, KN, VNT, AO, args.in[I_RPB]);
    }
    SEAM(2);

    if (IN(3)) { const int tid = fresh_tid(), lane = tid & 63; (void)tid; (void)lane;
        pg8::Gemm g{AO, W_AO, NTOK, DM, DM / 2, DM / 2}; pg8::StaticOrder S; S.init(NTOK, DM, G, bid);
        pg8::EpiResidT<true> E{x, H, DM, 1.0f / 64.0f};
        pg8::gemm_phase(lds, g, S, E);
    }
    SEAM(3);

    if (IN(4)) { const int tid = fresh_tid(), lane = tid & 63; (void)tid; (void)lane; for (int m = gw; m < NTOK; m += NGW) rms_row_bf16(H + (size_t)m * DM, args.in[I_LN_FFN], HN + (size_t)m * DM, lane); }
    SEAM(4);

    if (IN(5)) { const int tid = fresh_tid(), lane = tid & 63; (void)tid; (void)lane;
        pg8::Gemm g{HN, W_GU, NTOK, 2 * DFF, DM, DM}; pg8::StaticOrder S; S.init(NTOK, 2 * DFF, G, bid);
        pg8::EpiSwiGLU E{MID, DFF};
        pg8::gemm_phase(lds, g, S, E);
    }
    SEAM(5);

    if (IN(6)) { const int tid = fresh_tid(), lane = tid & 63; (void)tid; (void)lane;
        pg8::Gemm g{MID, W_FD, NTOK, DM, DFF, DFF}; pg8::StaticOrder S; S.init(NTOK, DM, G, bid);
        pg8::EpiResid E{H, H, DM, 1.0f};
        pg8::gemm_phase(lds, g, S, E);
    }
    SEAM(6);

    if (IN(7)) { const int tid = fresh_tid(), lane = tid & 63; (void)tid; (void)lane; for (int m = gw; m < NTOK; m += NGW) rms_row_bf16(H + (size_t)m * DM, args.in[I_LN_PLE], HN + (size_t)m * DM, lane); }
    SEAM(7);

    if (IN(8)) { const int tid = fresh_tid(), lane = tid & 63; (void)tid; (void)lane;
        pg8::Gemm g{HN, W_PG, NTOK, DM, DM, DM}; pg8::StaticOrder S; S.init(NTOK, DM, G, bid);
        pg8::EpiPle E{H, PP, DM};
        pg8::gemm_phase(lds, g, S, E);
    }
    SEAM(8);

    if (IN(9)) { const int tid = fresh_tid(), lane = tid & 63; (void)tid; (void)lane; for (int m = gw; m < NTOK; m += NGW) rms_row_bf16(H + (size_t)m * DM, args.in[I_LN_MIX] + DM, HN + (size_t)m * DM, lane); }
    SEAM(9);

    if (IN(10)) { const int tid = fresh_tid(), lane = tid & 63; (void)tid; (void)lane;
        pg8::Gemm g{HN, W_HI, NTOK, 6144, DM, DM}; pg8::StaticOrder S; S.init(NTOK, 6144, G, bid);
        pg8::EpiProjT E{PROJT, args.in[I_B_HI], NTOK};
        pg8::gemm_phase(lds, g, S, E);
    }
    SEAM(10);

    if (IN(11)) { const int tid = fresh_tid(), lane = tid & 63; (void)tid; (void)lane;
        for (int u = bid; u < 512; u += G) hyena_conv_unit(u, wave, lane, lds, PROJT, FILT, args.in[I_W_HC], args.in[I_B_HC], args.in[I_HYB], ZFT);
    }
    SEAM(11);

    if (IN(12)) { const int tid = fresh_tid(), lane = tid & 63; (void)tid; (void)lane; LAS unsigned short* tl = (LAS unsigned short*)(lds + wave * 16384); for (int t = gw; t < 32 * 128; t += NGW) transpose_tile(t, lane, tl, ZFT, ZF); }
    SEAM(12);

    if (IN(13)) { const int tid = fresh_tid(), lane = tid & 63; (void)tid; (void)lane;
        pg8::Gemm g{ZF, W_HO, NTOK, DM, DM, DM}; pg8::StaticOrder S; S.init(NTOK, DM, G, bid);
        pg8::EpiResid E{H, H, DM, 1.0f};
        pg8::gemm_phase(lds, g, S, E);
    }
    SEAM(13);

    if (IN(14)) { const int tid = fresh_tid(), lane = tid & 63; (void)tid; (void)lane;
        LAS unsigned* lhist = (LAS unsigned*)(lds + 1024);
        for (int tb = bid; tb < 256; tb += G) {
            if (tid < 8) lhist[tid] = 0u;
            __syncthreads();
            for (int i = 0; i < 4; ++i) router_token(tb * 32 + wave * 4 + i, lane, H, args.in[I_LN_FFN] + DM, args.in[I_W_RT], HN, ctl, lhist);
            __syncthreads();
            if (tid < 8) ctl[CW_HIST + tb * 8 + tid] = lhist[tid];
            __syncthreads();
        }
    }
    SEAM(14);

    if (IN(15)) { const int tid = fresh_tid(), lane = tid & 63; (void)tid; (void)lane;
        LAS unsigned* lw = (LAS unsigned*)(lds + 1024);
        for (int tb = bid; tb < 256; tb += G) {
            { const int e = tid & 7, q = tid >> 3;
              unsigned tot = 0u, bef = 0u;
#pragma unroll
              for (int i = 0; i < 4; ++i) { const int t2 = 4 * q + i; const unsigned h = ctl[CW_HIST + t2 * 8 + e]; tot += h; bef += (t2 < tb) ? h : 0u; }
#pragma unroll
              for (int o = 8; o < 64; o <<= 1) { tot += __shfl_xor(tot, o); bef += __shfl_xor(bef, o); }
              if (lane < 8) { lw[32 + wave * 16 + lane] = tot; lw[32 + wave * 16 + 8 + lane] = bef; } }
            __syncthreads();
            if (tid < 8) { unsigned tot = 0u, bef = 0u;
#pragma unroll
                for (int w = 0; w < 8; ++w) { tot += lw[32 + w * 16 + tid]; bef += lw[32 + w * 16 + 8 + tid]; }
                lw[tid] = bef; lw[16 + tid] = tot; }
            __syncthreads();
            if (tid == 0) { unsigned st = 0u; int nt = 0;
                for (int e = 0; e < 8; ++e) { lw[8 + e] = st; const unsigned tiles = (lw[16 + e] + 255u) >> 8;
                    if (tb == 0) for (unsigned q = 0; q < tiles; ++q) ctl[CW_TILEEXP + nt + (int)q] = (unsigned)e;
                    nt += (int)tiles; st += tiles << 8; }
                if (tb == 0) ctl[CW_TILEEXP + MAXTILES] = (unsigned)nt; }
            __syncthreads();
            if (wave == 0) { const int tok = tb * 32 + (lane >> 1), k = lane & 1; const unsigned e = ctl[CW_TOKE + 2 * tok + k];
                unsigned rank = 0u;
#pragma unroll
                for (unsigned q = 0; q < 8; ++q) { const unsigned long long mk = __ballot(e == q); if (e == q) rank = (unsigned)__popcll(mk & ((1ull << lane) - 1ull)); }
                const unsigned slot = lw[8 + e] + lw[e] + rank;
                ctl[CW_TOKS + 2 * tok + k] = slot; lw[192 + lane] = slot; }
            __syncthreads();
            for (int q = 0; q < 8; ++q) { const int ent = wave * 8 + q; const int tok = tb * 32 + (ent >> 1); const unsigned slot = lw[192 + ent];
                const u32x4* src = (const u32x4*)((const unsigned char*)HN + (size_t)tok * DM) + lane; u32x4* dst = (u32x4*)((unsigned char*)XS + (size_t)slot * DM) + lane;
#pragma unroll
                for (int i = 0; i < 2; ++i) dst[64 * i] = src[64 * i]; }
            __syncthreads();
        }
    }
    SEAM(15);

    if (IN(16)) { const int tid = fresh_tid(), lane = tid & 63; (void)tid; (void)lane;
        const int ntl = (int)__builtin_amdgcn_readfirstlane(ctl[CW_TILEEXP + MAXTILES]);
        pg8::Gemm g{XS, W_EGU, ntl * 256, 2 * DFFE, DM / 2, DM / 2}; pg8::GroupedOrder S; S.init(ntl * 256, 2 * DFFE, G, bid); S.tile_exp = (const int*)(ctl + CW_TILEEXP); S.estride = (size_t)2 * DFFE * DM / 2;
        if (bid == 0) { pg8::StaticOrder T; T.init(ntl * 256, DM, 1, 0); const int nun = ntl * 8, full = (nun / G) * G, tail = nun - full;
            int Sp = 1;
            if (14 * tail <= G) Sp = 14; else if (7 * tail <= G) Sp = 7; else if (4 * tail <= G) Sp = 4; else if (2 * tail <= G) Sp = 2;
            if (tid < tail) { pg8::Unit tu; T.unit_at(full + tid, tu); ctl[CW_TAILMAP + tu.pm * 8 + tu.pn] = 1u + (unsigned)tid; }
            if (tid == 0) ctl[CW_TAILSP] = (unsigned)Sp; }
        pg8::EpiSwiGLU8 E{(unsigned char*)HMID, DFFE};
        pg8::gemm_phase(lds, g, S, E);
    }
    SEAM(16);

    if (IN(17)) { const int tid = fresh_tid(), lane = tid & 63; (void)tid; (void)lane;
        const int ntl = (int)__builtin_amdgcn_readfirstlane(ctl[CW_TILEEXP + MAXTILES]);
        pg8::Gemm g{HMID, W_ED, ntl * 256, DM, DFFE / 2, DFFE / 2}; pg8::GroupedOrder S; S.init(ntl * 256, DM, G, bid); S.tile_exp = (const int*)(ctl + CW_TILEEXP); S.estride = (size_t)DM * DFFE / 2;
        const int nun = ntl * 8, full = (nun / G) * G, tail = nun - full;
        S.limit = full;
        pg8::EpiF32s8 E{Y, DM, 1.0f / 64.0f};
        pg8::gemm_phase(lds, g, S, E);
        if (tail > 0) {
            const int Sp = (int)__builtin_amdgcn_readfirstlane(ctl[CW_TAILSP]);
            pg8::TailOrder T; T.init(ntl * 256, DM, G, bid); T.tile_exp = S.tile_exp; T.estride = S.estride; T.first = full; T.ntail = tail; T.S = Sp; T.kslice = DFFE / 2 / Sp;
            pg8::Gemm g2{HMID, W_ED, ntl * 256, DM, DFFE / 2 / Sp, DFFE / 2};
            pg8::EpiPartTile8 E2{(float*)(ws + WS_XS), 1.0f / 64.0f};
            pg8::gemm_phase(lds, g2, T, E2);
        }
    }
    SEAM(17);

    if (IN(18)) { const int tid = fresh_tid(), lane = tid & 63; (void)tid; (void)lane;
        for (int m = gw; m < NTOK; m += NGW) {
            const unsigned s0 = ctl[CW_TOKS + 2 * m], s1 = ctl[CW_TOKS + 2 * m + 1];
            const float g0 = __builtin_bit_cast(float, ctl[CW_TOKG + 2 * m]), g1 = __builtin_bit_cast(float, ctl[CW_TOKG + 2 * m + 1]);
            f32x4* hr = (f32x4*)(H + (size_t)m * DM) + lane; const f32x4* y0 = (const f32x4*)(Y + (size_t)s0 * DM) + lane; const f32x4* y1 = (const f32x4*)(Y + (size_t)s1 * DM) + lane;
            const float* YP = (const float*)(ws + WS_XS); const int Sp = (int)ctl[CW_TAILSP];
            f32x4 v[8]; float ss = 0.f;
#pragma unroll
            for (int j = 0; j < 8; ++j) {
                f32x4 a0, a1;
                const unsigned t0 = ctl[CW_TAILMAP + (s0 >> 8) * 8 + j], t1 = ctl[CW_TAILMAP + (s1 >> 8) * 8 + j];
                if (t0 == 0u) a0 = y0[64 * j]; else { a0 = (f32x4){0.f, 0.f, 0.f, 0.f}; const f32x4* pp = (const f32x4*)(YP + (size_t)((t0 - 1u) * Sp) * 65536 + (size_t)(s0 & 255u) * 256) + lane; for (int q = 0; q < Sp; ++q) a0 += pp[(size_t)q * 16384]; }
                if (t1 == 0u) a1 = y1[64 * j]; else { a1 = (f32x4){0.f, 0.f, 0.f, 0.f}; const f32x4* pp = (const f32x4*)(YP + (size_t)((t1 - 1u) * Sp) * 65536 + (size_t)(s1 & 255u) * 256) + lane; for (int q = 0; q < Sp; ++q) a1 += pp[(size_t)q * 16384]; }
                v[j] = hr[64 * j] + (a0 * g0 + a1 * g1); hr[64 * j] = v[j]; ss += (v[j][0] * v[j][0] + v[j][1] * v[j][1]) + (v[j][2] * v[j][2] + v[j][3] * v[j][3]); }
            const float rstd = 1.0f / sqrtf(wave_sum(ss) * (1.f / DM) + RMS_EPS);
            const f32x4* gr = (const f32x4*)(args.in[I_LN_PLE] + DM) + lane; unsigned* o8 = (unsigned*)((unsigned char*)HN + (size_t)m * DM) + lane;
#pragma unroll
            for (int j = 0; j < 8; ++j) { const f32x4 g = gr[64 * j]; o8[64 * j] = pk4_fp8(v[j][0] * rstd * g[0], v[j][1] * rstd * g[1], v[j][2] * rstd * g[2], v[j][3] * rstd * g[3]); }
        }
    }
    SEAM(18);

    if (IN(19)) { const int tid = fresh_tid(), lane = tid & 63; (void)tid; (void)lane;
        pg8::Gemm g{HN, (const bf16*)(ws + WS_PG8), NTOK, DM, DM / 2, DM / 2}; pg8::StaticOrder S; S.init(NTOK, DM, G, bid);
        pg8::EpiPle8 E{H, PP + (size_t)NTOK * DM, DM};
        pg8::gemm_phase(lds, g, S, E);
    }
    SEAM(19);

    if (LAST_PHASE < 19 && lo <= 19 && 20 < hi) GRID_BAR();
    if (IN(20)) { const int tid = fresh_tid(), lane = tid & 63; (void)tid; (void)lane;
        const float* src = (LAST_PHASE < 3) ? x : H;
        for (int m = gw; m < NTOK; m += NGW) rms_row_f32(src + (size_t)m * DM, args.in[I_FINAL], args.out + (size_t)m * DM, lane);
    }
#undef IN
#undef SEAM
}

extern "C" void kernel_launch(void* const* d_in, const int* in_sizes, int n_in, void* d_out, int out_size, void* d_ws, size_t ws_size, hipStream_t stream) {
    static int grid = 0;
    if (grid == 0) {
        if (n_in != 32 || out_size != NTOK * DM || ws_size < WS_END) { fprintf(stderr, "kernel_launch: unexpected shapes: n_in %d out %d ws %zu (need %zu)\n", n_in, out_size, ws_size, (size_t)WS_END); grid = -1; return; }
        int dev = 0, cus = 0, per_cu = 0;
        if (hipGetDevice(&dev) != hipSuccess || hipDeviceGetAttribute(&cus, hipDeviceAttributeMultiprocessorCount, dev) != hipSuccess) { grid = -1; return; }
        if (hipFuncSetAttribute((const void*)fwd_kernel, hipFuncAttributeMaxDynamicSharedMemorySize, LDS_BYTES) != hipSuccess) { fprintf(stderr, "kernel_launch: hipFuncSetAttribute failed\n"); grid = -1; return; }
        if (hipOccupancyMaxActiveBlocksPerMultiprocessor(&per_cu, (const void*)fwd_kernel, NTHR, LDS_BYTES) != hipSuccess || per_cu < 1) fprintf(stderr, "kernel_launch: occupancy query reports %d\n", per_cu);
        (void)hipGetLastError();
        grid = cus;
    }
    if (grid < 0) return;
    if (hipMemsetAsync((char*)d_ws + WS_CTL, 0, CTL_BYTES, stream) != hipSuccess) return;
    Args a{};
    for (int i = 0; i < 32; ++i) a.in[i] = (const float*)d_in[i];
    a.out = (float*)d_out; a.ws = (unsigned char*)d_ws;
#if MK_ONE_LAUNCH
    a.ph_lo = 0; a.ph_hi = 64;
    hipLaunchKernelGGL(fwd_kernel, dim3(grid), dim3(NTHR), LDS_BYTES, stream, a);
#else
    for (int ph = 0; ph <= 20; ++ph) {
        if (ph > LAST_PHASE && ph != 20) continue;

        a.ph_lo = ph; a.ph_hi = ph + 1;
        hipLaunchKernelGGL(fwd_kernel, dim3(grid), dim3(NTHR), LDS_BYTES, stream, a);
    }
#endif
}
```

```cpp
#include <hip/hip_runtime.h>
#include <cstdio>
#include <cstdint>

#ifndef MK_ONE_LAUNCH
#define MK_ONE_LAUNCH 1
#endif
#ifndef LAST_PHASE
#define LAST_PHASE 99
#endif

#define GAS __attribute__((address_space(1)))
#define LAS __attribute__((address_space(3)))
typedef unsigned short bf16;
typedef short bf16x8 __attribute__((ext_vector_type(8)));
typedef short bf16x4 __attribute__((ext_vector_type(4)));
typedef float f32x4 __attribute__((ext_vector_type(4)));
typedef float f32x2 __attribute__((ext_vector_type(2)));
typedef unsigned u32x4 __attribute__((ext_vector_type(4)));
typedef unsigned u32x2 __attribute__((ext_vector_type(2)));
typedef int v8i __attribute__((ext_vector_type(8)));
typedef int v4i __attribute__((ext_vector_type(4)));

constexpr int NTOK = 8192, SEQ = 4096, DM = 2048;
constexpr int DFF = 5632, DFFE = 7168, NEXP = 8;
constexpr int HYW = 2048;
constexpr float RMS_EPS = 1e-6f;
constexpr int NWAVES = 8, NTHR = 512;
constexpr int MAXTILES = 72;

constexpr size_t MiB = 1u << 20;
constexpr size_t WS_CTL = 0, CTL_BYTES = 1 * MiB;
constexpr size_t WS_W_QK = 2 * MiB;
constexpr size_t WS_W_V = WS_W_QK + 12 * MiB;
constexpr size_t WS_W_AO = WS_W_V + 5 * MiB;
constexpr size_t WS_W_GU = WS_W_AO + 8 * MiB;
constexpr size_t WS_W_FD = WS_W_GU + 44 * MiB;
constexpr size_t WS_W_PG = WS_W_FD + 22 * MiB;
constexpr size_t WS_W_PP = WS_W_PG + 16 * MiB;
constexpr size_t WS_W_HI = WS_W_PP + 2 * MiB;
constexpr size_t WS_W_HO = WS_W_HI + 24 * MiB;
constexpr size_t WS_W_EGU = WS_W_HO + 8 * MiB;
constexpr size_t WS_W_ED = WS_W_EGU + 448 * MiB;
constexpr size_t WS_H = WS_W_ED + 224 * MiB;
constexpr size_t WS_HN = WS_H + 64 * MiB;
constexpr size_t WS_PP = WS_HN + 32 * MiB;
constexpr size_t WS_PB = WS_PP + 64 * MiB;
constexpr size_t WS_FILT = WS_PB + 8 * MiB;
constexpr size_t WS_AF = WS_FILT + 64 * MiB;
constexpr size_t WS_BF = WS_AF + 2 * MiB;
constexpr size_t WS_SCR = WS_BF + 4 * MiB;
constexpr size_t WS_QA = WS_SCR;
constexpr size_t WS_QN = WS_QA + 16 * MiB;
constexpr size_t WS_KN = WS_QN + 16 * MiB;
constexpr size_t WS_KA = WS_KN + 16 * MiB;
constexpr size_t WS_VAT = WS_KA + 2 * MiB;
constexpr size_t WS_VNT = WS_VAT + 2 * MiB;
constexpr size_t WS_AO = WS_VNT + 16 * MiB;
constexpr size_t WS_MID = WS_AO + 32 * MiB;
constexpr size_t WS_XS = WS_SCR;
constexpr size_t WS_HMID = WS_XS + 72 * MiB;
constexpr size_t WS_Y = WS_HMID + 252 * MiB;
constexpr size_t WS_PROJT = WS_HMID;
constexpr size_t WS_ZFT = WS_PROJT + 96 * MiB;
constexpr size_t WS_ZF = WS_ZFT + 32 * MiB;
constexpr size_t WS_RSC = WS_Y + 144 * MiB;
constexpr size_t WS_PG8 = WS_RSC + 1 * MiB;
constexpr size_t WS_H1 = WS_PG8 + 4 * MiB;
constexpr size_t WS_END = WS_H1 + 1 * MiB;
static_assert(WS_MID + 88 * MiB <= WS_END && WS_ZF + 32 * MiB <= WS_Y, "ws map");
constexpr int CW_BAR = 4096;
constexpr int CW_HIST = 16384;
constexpr int CW_TILEEXP = 20480;
constexpr int CW_WSC = 22528;
constexpr int CW_TAILMAP = 24576;
constexpr int CW_TAILSP = CW_TAILMAP + 640;
constexpr int CW_TOKE = 32768;
constexpr int CW_TOKG = CW_TOKE + 16384;
constexpr int CW_TOKS = CW_TOKG + 16384;
static_assert((CW_TOKS + 16384) * 4 <= (int)CTL_BYTES, "ctl");

constexpr int RING_BYTES = 131072;
constexpr int LDS_BYTES = 163840;
constexpr int MISC_OFF = LDS_BYTES - 256;

__device__ __forceinline__ unsigned f2bf(float f) { unsigned u = __builtin_bit_cast(unsigned, f); return (u + 0x7fffu + ((u >> 16) & 1u)) >> 16; }
__device__ __forceinline__ unsigned pk2(float lo, float hi) { unsigned r; asm volatile("v_cvt_pk_bf16_f32 %0, %1, %2" : "=v"(r) : "v"(lo), "v"(hi)); return r; }
__device__ __forceinline__ float bf2f(unsigned short b) { return __builtin_bit_cast(float, ((unsigned)b) << 16); }
__device__ __forceinline__ float bflo(unsigned w) { return __builtin_bit_cast(float, w << 16); }
__device__ __forceinline__ float bfhi(unsigned w) { return __builtin_bit_cast(float, w & 0xffff0000u); }
__device__ __forceinline__ unsigned pk4_fp8(float a, float b, float c, float d) { int w = 0; w = __builtin_amdgcn_cvt_pk_fp8_f32(a, b, w, false); w = __builtin_amdgcn_cvt_pk_fp8_f32(c, d, w, true); return (unsigned)w; }
__device__ __forceinline__ unsigned pk4_i8(float a, float b, float c, float d) {
    const int i0 = (int)__builtin_rintf(fminf(fmaxf(a, -127.f), 127.f)), i1 = (int)__builtin_rintf(fminf(fmaxf(b, -127.f), 127.f));
    const int i2 = (int)__builtin_rintf(fminf(fmaxf(c, -127.f), 127.f)), i3 = (int)__builtin_rintf(fminf(fmaxf(d, -127.f), 127.f));
    return (unsigned)(i0 & 255) | ((unsigned)(i1 & 255) << 8) | ((unsigned)(i2 & 255) << 16) | ((unsigned)i3 << 24);
}
__device__ __forceinline__ float wave_max(float v) {
#pragma unroll
    for (int o = 1; o < 64; o <<= 1) v = fmaxf(v, __shfl_xor(v, o));
    return v;
}
__device__ __forceinline__ float wave_sum(float v) {
#pragma unroll
    for (int o = 1; o < 64; o <<= 1) v += __shfl_xor(v, o);
    return v;
}
#define LDS_WAIT() asm volatile("s_waitcnt lgkmcnt(0)" ::: "memory")
#define VM_WAIT() asm volatile("s_waitcnt vmcnt(0)" ::: "memory")

namespace pg8 {
constexpr int BM = 256, BK = 64, HALF = 128, HTB = HALF * BK * 2, STAGE_BYTES = 8 * HTB, NXCD = 8, WGM = 8;
__host__ __device__ __forceinline__ int lds_byte(int r, int c) { const int st = (r >> 4) * 2 + (c >> 5), rr = r & 15, cc = c & 31, ob = rr * 64 + cc * 2; return st * 1024 + (ob ^ (((ob >> 9) & 1) << 5)); }
__host__ __device__ __forceinline__ void stage_rc(int b, int& R, int& C) { const int st = b / 1024, sb = b % 1024, swz = sb ^ (((sb >> 9) & 1) << 5); R = (st >> 1) * 16 + swz / 64; C = (st & 1) * 32 + (swz % 64) / 2; }
__host__ __device__ __forceinline__ int perm32(int rho) { const int n = rho >> 4, i = rho & 15; return 8 * (i >> 2) + 4 * n + (i & 3); }

struct Unit { int pm, pn, kofs, aux; };
struct Gemm { const bf16* A; const bf16* Bt; int M, N, K, ld; };

struct StaticOrder {
    int nM, nN, nwg, G, c, limit;
    __device__ __forceinline__ void init(int M, int N, int G_, int c_) { nM = M / BM; nN = N / BM; nwg = nM * nN; G = G_; c = c_; limit = nwg; }
    __device__ __forceinline__ void unit_at(int L, Unit& u) const {
        int wgid = L; { const int q = nwg / NXCD, r = nwg % NXCD, xcd = wgid % NXCD, off = wgid / NXCD; wgid = (xcd < r ? xcd * (q + 1) : r * (q + 1) + (xcd - r) * q) + off; }
        const int nig = WGM * nN, gid = wgid / nig, fm = gid * WGM, gsz = (nM - fm) < WGM ? (nM - fm) : WGM;
        u.pm = fm + ((wgid % nig) % gsz); u.pn = (wgid % nig) / gsz; u.kofs = 0; u.aux = 0;
    }
    __device__ __forceinline__ bool next(int i, Unit& u) const {
        const long L = (long)i * G + c; if (L >= limit) return false;
        unit_at((int)L, u); return true;
    }
    __device__ __forceinline__ unsigned boffs(const Gemm& g, const Unit& u, unsigned tstep) const { return (unsigned)u.pn * tstep; }
};
struct GroupedOrder : StaticOrder {
    const int* tile_exp; size_t estride;
    __device__ __forceinline__ unsigned boffs(const Gemm& g, const Unit& u, unsigned tstep) const {
        const int e = __builtin_amdgcn_readfirstlane(tile_exp[u.pm]);
        return (unsigned)e * (unsigned)(estride * 2) + (unsigned)u.pn * tstep; }
};
struct TailOrder : GroupedOrder {
    int first, ntail, S, kslice;
    __device__ __forceinline__ bool next(int i, Unit& u) const {
        const long j = (long)i * G + c; if (j >= (long)ntail * S) return false;
        const int tu = (int)(j / S), sl = (int)(j % S); unit_at(first + tu, u); u.kofs = sl * kslice; u.aux = (int)j; return true;
    }
};

template <class Epi, class Sched>
__device__ __forceinline__ void gemm_phase(LAS unsigned char* lds, const Gemm g, const Sched& S, const Epi& E) {
    int tid = threadIdx.x; asm volatile("" : "+v"(tid));
    const int wid = __builtin_amdgcn_readfirstlane(tid >> 6), lane = tid & 63, wr = wid >> 2, wc = wid & 3, fr = lane & 15, fq = lane >> 4;
    const int K = g.ld, nt = g.K / BK;
    unsigned voffA, voffB;
    { int R, C; stage_rc(tid * 16, R, C); const int Rb = Epi::PERM ? ((R & ~31) + perm32(R & 31)) : R;
        voffA = (unsigned)(R * K + C) * 2u; voffB = (unsigned)(Rb * K + C) * 2u; }
    const unsigned qstep = 64u * (unsigned)K * 2u;
    const unsigned kstep = (unsigned)(BK * 2);
    const unsigned hstep = (unsigned)HALF * (unsigned)K * 2u;
    const unsigned tstep = 2u * hstep;
    const __amdgpu_buffer_rsrc_t rsA = __builtin_amdgcn_make_buffer_rsrc((void*)g.A, 0, 0x7fffffff, 0x00020000);
    const __amdgpu_buffer_rsrc_t rsB = __builtin_amdgcn_make_buffer_rsrc((void*)g.Bt, 0, 0x7fffffff, 0x00020000);
    const unsigned ldsw = (unsigned)wid * 1024u;
    const int aoff = lds_byte(wr * 64 + fr, fq * 8), boff = lds_byte(wc * 32 + fr, fq * 8);
#define PG8_SA(b, h) (((b) * 2 + (h)) * HTB)
#define PG8_SB(b, h) ((4 + (b) * 2 + (h)) * HTB)
#define PG8_STAGE(bufoff, rs, soff, voff) do { _Pragma("unroll") for (int _i = 0; _i < 2; ++_i) \
        __builtin_amdgcn_raw_ptr_buffer_load_lds(rs, (LAS unsigned*)(lds + (bufoff) + ldsw + _i * 8192), 16, (voff), (soff) + _i * qstep, 0, 0); } while (0)
#define PG8_LDA(dst, b, h) do { _Pragma("unroll") for (int m = 0; m < 4; ++m) { const v4i _lo = *(const LAS v4i*)(lds + PG8_SA(b, h) + aoff + m * 2048), _hi = *(const LAS v4i*)(lds + PG8_SA(b, h) + aoff + m * 2048 + 1024); \
        dst[m] = __builtin_shufflevector(_lo, _hi, 0, 1, 2, 3, 4, 5, 6, 7); } } while (0)
#define PG8_LDB(dst, b, h) do { _Pragma("unroll") for (int n = 0; n < 2; ++n) { const v4i _lo = *(const LAS v4i*)(lds + PG8_SB(b, h) + boff + n * 2048), _hi = *(const LAS v4i*)(lds + PG8_SB(b, h) + boff + n * 2048 + 1024); \
        dst[n] = __builtin_shufflevector(_lo, _hi, 0, 1, 2, 3, 4, 5, 6, 7); } } while (0)
#define PG8_MMA(ai, bj, At, Bt) do { __builtin_amdgcn_s_setprio(1); \
        if constexpr (Epi::I8) { _Pragma("unroll") for (int m = 0; m < 4; ++m) _Pragma("unroll") for (int n = 0; n < 2; ++n) { \
            const v4i a0 = __builtin_shufflevector(At[m], At[m], 0, 1, 2, 3), a1 = __builtin_shufflevector(At[m], At[m], 4, 5, 6, 7), b0 = __builtin_shufflevector(Bt[n], Bt[n], 0, 1, 2, 3), b1 = __builtin_shufflevector(Bt[n], Bt[n], 4, 5, 6, 7); \
            v4i c_ = __builtin_bit_cast(v4i, acc[ai][bj][m][n]); \
            c_ = Epi::TRANS ? __builtin_amdgcn_mfma_i32_16x16x64_i8(b0, a0, c_, 0, 0, 0) : __builtin_amdgcn_mfma_i32_16x16x64_i8(a0, b0, c_, 0, 0, 0); \
            c_ = Epi::TRANS ? __builtin_amdgcn_mfma_i32_16x16x64_i8(b1, a1, c_, 0, 0, 0) : __builtin_amdgcn_mfma_i32_16x16x64_i8(a1, b1, c_, 0, 0, 0); \
            acc[ai][bj][m][n] = __builtin_bit_cast(f32x4, c_); } } \
        else if constexpr (Epi::FP8) { _Pragma("unroll") for (int m = 0; m < 4; ++m) _Pragma("unroll") for (int n = 0; n < 2; ++n) \
            acc[ai][bj][m][n] = Epi::TRANS ? __builtin_amdgcn_mfma_scale_f32_16x16x128_f8f6f4(Bt[n], At[m], acc[ai][bj][m][n], 0, 0, 0, 0x7f7f7f7f, 0, 0x7f7f7f7f) \
                                           : __builtin_amdgcn_mfma_scale_f32_16x16x128_f8f6f4(At[m], Bt[n], acc[ai][bj][m][n], 0, 0, 0, 0x7f7f7f7f, 0, 0x7f7f7f7f); } \
        else { _Pragma("unroll") for (int m = 0; m < 4; ++m) _Pragma("unroll") for (int n = 0; n < 2; ++n) { \
            const bf16x8 a0 = __builtin_bit_cast(bf16x8, __builtin_shufflevector(At[m], At[m], 0, 1, 2, 3)), a1 = __builtin_bit_cast(bf16x8, __builtin_shufflevector(At[m], At[m], 4, 5, 6, 7)), \
                         b0 = __builtin_bit_cast(bf16x8, __builtin_shufflevector(Bt[n], Bt[n], 0, 1, 2, 3)), b1 = __builtin_bit_cast(bf16x8, __builtin_shufflevector(Bt[n], Bt[n], 4, 5, 6, 7)); \
            acc[ai][bj][m][n] = Epi::TRANS ? __builtin_amdgcn_mfma_f32_16x16x32_bf16(b0, a0, acc[ai][bj][m][n], 0, 0, 0) : __builtin_amdgcn_mfma_f32_16x16x32_bf16(a0, b0, acc[ai][bj][m][n], 0, 0, 0); \
            acc[ai][bj][m][n] = Epi::TRANS ? __builtin_amdgcn_mfma_f32_16x16x32_bf16(b1, a1, acc[ai][bj][m][n], 0, 0, 0) : __builtin_amdgcn_mfma_f32_16x16x32_bf16(a1, b1, acc[ai][bj][m][n], 0, 0, 0); } } \
        __builtin_amdgcn_s_setprio(0); } while (0)
#define PG8_WAIT_V(n) asm volatile("s_waitcnt vmcnt(" #n ")" ::: "memory")
#define PG8_WAIT_L(n) asm volatile("s_waitcnt lgkmcnt(" #n ")" ::: "memory")
#define PG8_BAR __builtin_amdgcn_s_barrier()
#define PG8_SCHED __builtin_amdgcn_sched_barrier(0)
    Unit cur, nxt; int ui = 0;
    if (!S.next(0, cur)) return;
    f32x4 acc[2][2][4][2];
#pragma unroll
    for (int a = 0; a < 2; ++a)
#pragma unroll
        for (int b = 0; b < 2; ++b)
#pragma unroll
            for (int m = 0; m < 4; ++m)
#pragma unroll
                for (int n = 0; n < 2; ++n) acc[a][b][m][n] = (f32x4){0.f, 0.f, 0.f, 0.f};
    v8i At[4], B0[2], B1[2];
    unsigned cA = (unsigned)cur.pm * tstep + (unsigned)cur.kofs * 2u, cB = S.boffs(g, cur, tstep) + (unsigned)cur.kofs * 2u;
    PG8_STAGE(PG8_SB(0, 0), rsB, cB, voffB); PG8_STAGE(PG8_SB(0, 1), rsB, cB + hstep, voffB); PG8_STAGE(PG8_SA(0, 0), rsA, cA, voffA); PG8_STAGE(PG8_SA(0, 1), rsA, cA + hstep, voffA);
    if (wr == 1) PG8_BAR;
    PG8_WAIT_V(2); PG8_BAR;
    PG8_STAGE(PG8_SB(1, 0), rsB, cB + kstep, voffB); PG8_STAGE(PG8_SA(1, 0), rsA, cA + kstep, voffA); PG8_STAGE(PG8_SB(1, 1), rsB, cB + hstep + kstep, voffB);
    PG8_WAIT_V(6); PG8_BAR;
    for (;;) {
        const bool has_next = S.next(ui + 1, nxt);
        const unsigned nA = has_next ? (unsigned)nxt.pm * tstep + (unsigned)nxt.kofs * 2u : cA, nB = has_next ? S.boffs(g, nxt, tstep) + (unsigned)nxt.kofs * 2u : cB;
        for (int t = 0; t < nt; t += 2) {
            const bool last = (t == nt - 2);
            const unsigned a1 = cA + (unsigned)(t + 1) * kstep;
            const unsigned a2 = last ? nA : cA + (unsigned)(t + 2) * kstep, b2 = last ? nB : cB + (unsigned)(t + 2) * kstep;
            const unsigned a3 = a2 + kstep, b3 = b2 + kstep;
            PG8_LDB(B0, 0, 0); PG8_LDB(B1, 0, 1); PG8_SCHED; PG8_LDA(At, 0, 0); PG8_STAGE(PG8_SA(1, 1), rsA, a1 + hstep, voffA);
            PG8_WAIT_V(8); PG8_WAIT_L(0); PG8_BAR; PG8_MMA(0, 0, At, B0); PG8_MMA(0, 1, At, B1); PG8_BAR; PG8_SCHED;
            PG8_LDA(At, 0, 1); PG8_STAGE(PG8_SB(0, 0), rsB, b2, voffB); PG8_STAGE(PG8_SB(0, 1), rsB, b2 + hstep, voffB); PG8_STAGE(PG8_SA(0, 0), rsA, a2, voffA);
            PG8_WAIT_V(8); PG8_WAIT_L(0); PG8_BAR; PG8_MMA(1, 0, At, B0); PG8_MMA(1, 1, At, B1); PG8_BAR; PG8_SCHED;
            PG8_LDB(B0, 1, 0); PG8_LDB(B1, 1, 1); PG8_SCHED; PG8_LDA(At, 1, 0); PG8_STAGE(PG8_SA(0, 1), rsA, a2 + hstep, voffA);
            PG8_WAIT_V(8); PG8_WAIT_L(0); PG8_BAR; PG8_MMA(0, 0, At, B0); PG8_MMA(0, 1, At, B1); PG8_BAR; PG8_SCHED;
            PG8_LDA(At, 1, 1); PG8_STAGE(PG8_SB(1, 0), rsB, b3, voffB); PG8_STAGE(PG8_SB(1, 1), rsB, b3 + hstep, voffB); PG8_STAGE(PG8_SA(1, 0), rsA, a3, voffA);
            PG8_WAIT_V(8); PG8_WAIT_L(0); PG8_BAR; PG8_MMA(1, 0, At, B0); PG8_MMA(1, 1, At, B1); PG8_BAR; PG8_SCHED;
        }
        if (wr == 0) PG8_BAR;
        { int tz = threadIdx.x; asm volatile("" : "+v"(tz));
          const int ewid = tz >> 6, elane = tz & 63; E(acc, cur, ewid >> 2, ewid & 3, elane & 15, elane >> 4); }
        if (!has_next) break;
#pragma unroll
        for (int a = 0; a < 2; ++a)
#pragma unroll
            for (int b = 0; b < 2; ++b)
#pragma unroll
                for (int m = 0; m < 4; ++m)
#pragma unroll
                    for (int n = 0; n < 2; ++n) acc[a][b][m][n] = (f32x4){0.f, 0.f, 0.f, 0.f};
        cur = nxt; cA = nA; cB = nB; ++ui;
        if (wr == 1) PG8_BAR;
    }
    PG8_WAIT_V(0);
    PG8_BAR;
#undef PG8_SA
#undef PG8_SB
#undef PG8_STAGE
#undef PG8_LDA
#undef PG8_LDB
#undef PG8_MMA
#undef PG8_WAIT_V
#undef PG8_WAIT_L
#undef PG8_BAR
#undef PG8_SCHED
}

template <int MODE> struct EpiBf16T {
    static constexpr bool PERM = true, TRANS = true, FP8 = (MODE == 1), I8 = (MODE == 2);
    bf16* O; int ldc; int split_cols; size_t split_stride; float sc; const float* rsc;
    __device__ __forceinline__ void operator()(const f32x4 (&acc)[2][2][4][2], const Unit& u, int wr, int wc, int fr, int fq) const {
        const int row0 = u.pm * BM + wr * 64 + fr; int colt = u.pn * BM; bf16* base = O;
        if (split_cols) { const int t = colt / split_cols; base += (size_t)t * split_stride; colt -= t * split_cols; }
        const int col0 = colt + wc * 32 + 8 * fq;
#pragma unroll
        for (int ai = 0; ai < 2; ++ai)
#pragma unroll
            for (int m = 0; m < 4; ++m) { const int row = row0 + ai * HALF + m * 16; bf16* rowp = base + (size_t)row * ldc + col0;
                const float s_ = (MODE == 2) ? sc * rsc[row] : sc;
#pragma unroll
                for (int bj = 0; bj < 2; ++bj) { f32x4 v0, v1;
                    if constexpr (MODE == 2) { const v4i i0_ = __builtin_bit_cast(v4i, acc[ai][bj][m][0]), i1_ = __builtin_bit_cast(v4i, acc[ai][bj][m][1]);
                        v0 = (f32x4){(float)i0_[0], (float)i0_[1], (float)i0_[2], (float)i0_[3]} * s_; v1 = (f32x4){(float)i1_[0], (float)i1_[1], (float)i1_[2], (float)i1_[3]} * s_; }
                    else { v0 = acc[ai][bj][m][0] * s_; v1 = acc[ai][bj][m][1] * s_; }
                    u32x4 w; w.x = pk2(v0[0], v0[1]); w.y = pk2(v0[2], v0[3]); w.z = pk2(v1[0], v1[1]); w.w = pk2(v1[2], v1[3]);
                    *(u32x4*)(rowp + bj * HALF) = w; } }
    }
};
typedef EpiBf16T<0> EpiBf16;
template <bool F8> struct EpiResidT {
    static constexpr bool PERM = false, TRANS = true, FP8 = F8, I8 = false;
    const float* base; float* out; int ldc; float sc;
    __device__ __forceinline__ void operator()(const f32x4 (&acc)[2][2][4][2], const Unit& u, int wr, int wc, int fr, int fq) const {
        const int row0 = u.pm * BM + wr * 64 + fr, col0 = u.pn * BM + wc * 32 + 4 * fq;
#pragma unroll
        for (int ai = 0; ai < 2; ++ai)
#pragma unroll
            for (int m = 0; m < 4; ++m) { const size_t off = (size_t)(row0 + ai * HALF + m * 16) * ldc + col0;
#pragma unroll
                for (int bj = 0; bj < 2; ++bj)
#pragma unroll
                    for (int n = 0; n < 2; ++n) { const f32x4 b = *(const f32x4*)(base + off + bj * HALF + n * 16); *(f32x4*)(out + off + bj * HALF + n * 16) = b + acc[ai][bj][m][n] * sc; } }
    }
};
typedef EpiResidT<false> EpiResid;
struct EpiF32 {
    static constexpr bool PERM = false, TRANS = true, FP8 = false, I8 = false;
    float* out; int ldc;
    __device__ __forceinline__ void operator()(const f32x4 (&acc)[2][2][4][2], const Unit& u, int wr, int wc, int fr, int fq) const {
        const int row0 = u.pm * BM + wr * 64 + fr, col0 = u.pn * BM + wc * 32 + 4 * fq;
#pragma unroll
        for (int ai = 0; ai < 2; ++ai)
#pragma unroll
            for (int m = 0; m < 4; ++m) { const size_t off = (size_t)(row0 + ai * HALF + m * 16) * ldc + col0;
#pragma unroll
                for (int bj = 0; bj < 2; ++bj)
#pragma unroll
                    for (int n = 0; n < 2; ++n) *(f32x4*)(out + off + bj * HALF + n * 16) = acc[ai][bj][m][n]; }
    }
};
struct EpiPartTile {
    static constexpr bool PERM = false, TRANS = true, FP8 = false, I8 = false;
    float* YP;
    __device__ __forceinline__ void operator()(const f32x4 (&acc)[2][2][4][2], const Unit& u, int wr, int wc, int fr, int fq) const {
        float* base = YP + (size_t)u.aux * 65536 + (size_t)(wr * 64 + fr) * 256 + wc * 32 + 4 * fq;
#pragma unroll
        for (int ai = 0; ai < 2; ++ai)
#pragma unroll
            for (int m = 0; m < 4; ++m)
#pragma unroll
                for (int bj = 0; bj < 2; ++bj)
#pragma unroll
                    for (int n = 0; n < 2; ++n) *(f32x4*)(base + (size_t)(ai * HALF + m * 16) * 256 + bj * HALF + n * 16) = acc[ai][bj][m][n];
    }
};
struct EpiSwiGLU {
    static constexpr bool PERM = true, TRANS = true, FP8 = false, I8 = false;
    bf16* O; int ldc;
    __device__ __forceinline__ void operator()(const f32x4 (&acc)[2][2][4][2], const Unit& u, int wr, int wc, int fr, int fq) const {
        const int row0 = u.pm * BM + wr * 64 + fr, col0 = u.pn * HALF + wc * 32 + 8 * fq;
#pragma unroll
        for (int ai = 0; ai < 2; ++ai)
#pragma unroll
            for (int m = 0; m < 4; ++m) { bf16* rowp = O + (size_t)(row0 + ai * HALF + m * 16) * ldc + col0;
                float o[8];
#pragma unroll
                for (int n = 0; n < 2; ++n)
#pragma unroll
                    for (int i = 0; i < 4; ++i) { const float gt = acc[ai][0][m][n][i], up = acc[ai][1][m][n][i]; o[n * 4 + i] = gt * up * __builtin_amdgcn_rcpf(1.0f + __expf(-gt)); }
                u32x4 w; w.x = pk2(o[0], o[1]); w.y = pk2(o[2], o[3]); w.z = pk2(o[4], o[5]); w.w = pk2(o[6], o[7]);
                *(u32x4*)rowp = w; }
    }
};
struct EpiSwiGLUi8 {
    static constexpr bool PERM = true, TRANS = true, FP8 = false, I8 = true;
    bf16* O; int ldc; const float* rsc; float wg, wu;
    __device__ __forceinline__ void operator()(const f32x4 (&acc)[2][2][4][2], const Unit& u, int wr, int wc, int fr, int fq) const {
        const int row0 = u.pm * BM + wr * 64 + fr, col0 = u.pn * HALF + wc * 32 + 8 * fq;
#pragma unroll
        for (int ai = 0; ai < 2; ++ai)
#pragma unroll
            for (int m = 0; m < 4; ++m) { const int row = row0 + ai * HALF + m * 16; bf16* rowp = O + (size_t)row * ldc + col0;
                const float sa = rsc[row], sg = sa * wg, su = sa * wu;
                float o[8];
#pragma unroll
                for (int n = 0; n < 2; ++n) { const v4i ag = __builtin_bit_cast(v4i, acc[ai][0][m][n]), au = __builtin_bit_cast(v4i, acc[ai][1][m][n]);
#pragma unroll
                    for (int i = 0; i < 4; ++i) { const float gt = (float)ag[i] * sg, up = (float)au[i] * su; o[n * 4 + i] = gt * up * __builtin_amdgcn_rcpf(1.0f + __expf(-gt)); } }
                u32x4 w; w.x = pk2(o[0], o[1]); w.y = pk2(o[2], o[3]); w.z = pk2(o[4], o[5]); w.w = pk2(o[6], o[7]);
                *(u32x4*)rowp = w; }
    }
};
struct EpiSwiGLU8 {
    static constexpr bool PERM = true, TRANS = true, FP8 = true, I8 = false;
    unsigned char* O; int ldc;
    __device__ __forceinline__ void operator()(const f32x4 (&acc)[2][2][4][2], const Unit& u, int wr, int wc, int fr, int fq) const {
        const int row0 = u.pm * BM + wr * 64 + fr, col0 = u.pn * HALF + wc * 32 + 8 * fq;
#pragma unroll
        for (int ai = 0; ai < 2; ++ai)
#pragma unroll
            for (int m = 0; m < 4; ++m) { unsigned char* rowp = O + (size_t)(row0 + ai * HALF + m * 16) * ldc + col0;
                float o[8];
#pragma unroll
                for (int n = 0; n < 2; ++n)
#pragma unroll
                    for (int i = 0; i < 4; ++i) { const float gt = acc[ai][0][m][n][i] * (1.0f / 64.0f), up = acc[ai][1][m][n][i] * (1.0f / 64.0f); o[n * 4 + i] = gt * up * __builtin_amdgcn_rcpf(1.0f + __expf(-gt)); }
                u32x2 w; w.x = pk4_fp8(o[0], o[1], o[2], o[3]); w.y = pk4_fp8(o[4], o[5], o[6], o[7]);
                *(u32x2*)rowp = w; }
    }
};
struct EpiF32s8 {
    static constexpr bool PERM = false, TRANS = true, FP8 = true, I8 = false;
    float* out; int ldc; float scale;
    __device__ __forceinline__ void operator()(const f32x4 (&acc)[2][2][4][2], const Unit& u, int wr, int wc, int fr, int fq) const {
        const int row0 = u.pm * BM + wr * 64 + fr, col0 = u.pn * BM + wc * 32 + 4 * fq;
#pragma unroll
        for (int ai = 0; ai < 2; ++ai)
#pragma unroll
            for (int m = 0; m < 4; ++m) { const size_t off = (size_t)(row0 + ai * HALF + m * 16) * ldc + col0;
#pragma unroll
                for (int bj = 0; bj < 2; ++bj)
#pragma unroll
                    for (int n = 0; n < 2; ++n) *(f32x4*)(out + off + bj * HALF + n * 16) = acc[ai][bj][m][n] * scale; }
    }
};
struct EpiPartTile8 {
    static constexpr bool PERM = false, TRANS = true, FP8 = true, I8 = false;
    float* YP; float scale;
    __device__ __forceinline__ void operator()(const f32x4 (&acc)[2][2][4][2], const Unit& u, int wr, int wc, int fr, int fq) const {
        float* base = YP + (size_t)u.aux * 65536 + (size_t)(wr * 64 + fr) * 256 + wc * 32 + 4 * fq;
#pragma unroll
        for (int ai = 0; ai < 2; ++ai)
#pragma unroll
            for (int m = 0; m < 4; ++m)
#pragma unroll
                for (int bj = 0; bj < 2; ++bj)
#pragma unroll
                    for (int n = 0; n < 2; ++n) *(f32x4*)(base + (size_t)(ai * HALF + m * 16) * 256 + bj * HALF + n * 16) = acc[ai][bj][m][n] * scale;
    }
};
template <int MODE> struct EpiPleT {
    static constexpr bool PERM = false, TRANS = true, FP8 = false, I8 = (MODE == 2);
    float* h; const bf16* pp; int ldc; float sc; const float* rsc;
    __device__ __forceinline__ void operator()(const f32x4 (&acc)[2][2][4][2], const Unit& u, int wr, int wc, int fr, int fq) const {
        const int row0 = u.pm * BM + wr * 64 + fr, col0 = u.pn * BM + wc * 32 + 4 * fq;
#pragma unroll
        for (int ai = 0; ai < 2; ++ai)
#pragma unroll
            for (int m = 0; m < 4; ++m) { const size_t off = (size_t)(row0 + ai * HALF + m * 16) * ldc + col0;
#pragma unroll
                for (int bj = 0; bj < 2; ++bj)
#pragma unroll
                    for (int n = 0; n < 2; ++n) { const size_t o2 = off + bj * HALF + n * 16; const f32x4 b = *(const f32x4*)(h + o2); const u32x2 pw = *(const u32x2*)(pp + o2);
                        f32x4 a;
                        if constexpr (MODE == 2) { const v4i iv = __builtin_bit_cast(v4i, acc[ai][bj][m][n]); a = (f32x4){(float)iv[0], (float)iv[1], (float)iv[2], (float)iv[3]} * (sc * rsc[row0 + ai * HALF + m * 16]); }
                        else a = acc[ai][bj][m][n];
                        f32x4 r;
                        r[0] = b[0] + bflo(pw.x) * __builtin_amdgcn_rcpf(1.0f + __expf(-a[0])); r[1] = b[1] + bfhi(pw.x) * __builtin_amdgcn_rcpf(1.0f + __expf(-a[1]));
                        r[2] = b[2] + bflo(pw.y) * __builtin_amdgcn_rcpf(1.0f + __expf(-a[2])); r[3] = b[3] + bfhi(pw.y) * __builtin_amdgcn_rcpf(1.0f + __expf(-a[3]));
                        *(f32x4*)(h + o2) = r; } }
    }
};
typedef EpiPleT<0> EpiPle;
struct EpiPle8 {
    static constexpr bool PERM = false, TRANS = true, FP8 = true, I8 = false;
    float* h; const bf16* pp; int ldc;
    __device__ __forceinline__ void operator()(const f32x4 (&acc)[2][2][4][2], const Unit& u, int wr, int wc, int fr, int fq) const {
        const int row0 = u.pm * BM + wr * 64 + fr, col0 = u.pn * BM + wc * 32 + 4 * fq;
#pragma unroll
        for (int ai = 0; ai < 2; ++ai)
#pragma unroll
            for (int m = 0; m < 4; ++m) { const size_t off = (size_t)(row0 + ai * HALF + m * 16) * ldc + col0;
#pragma unroll
                for (int bj = 0; bj < 2; ++bj)
#pragma unroll
                    for (int n = 0; n < 2; ++n) { const size_t o2 = off + bj * HALF + n * 16; const f32x4 b = *(const f32x4*)(h + o2); const u32x2 pw = *(const u32x2*)(pp + o2);
                        const f32x4 a = acc[ai][bj][m][n] * (1.0f / 64.0f); f32x4 r;
                        r[0] = b[0] + bflo(pw.x) * __builtin_amdgcn_rcpf(1.0f + __expf(-a[0])); r[1] = b[1] + bfhi(pw.x) * __builtin_amdgcn_rcpf(1.0f + __expf(-a[1]));
                        r[2] = b[2] + bflo(pw.y) * __builtin_amdgcn_rcpf(1.0f + __expf(-a[2])); r[3] = b[3] + bfhi(pw.y) * __builtin_amdgcn_rcpf(1.0f + __expf(-a[3]));
                        *(f32x4*)(h + o2) = r; } }
    }
};
template <int MODE> struct EpiVT {
    static constexpr bool PERM = false, TRANS = false, FP8 = (MODE == 1), I8 = (MODE == 2);
    unsigned char* ws_;
    __device__ __forceinline__ void operator()(const f32x4 (&acc)[2][2][4][2], const Unit& u, int wr, int wc, int fr, int fq) const {
        bf16* KA = (bf16*)(ws_ + WS_KA); bf16* VAT = (bf16*)(ws_ + WS_VAT); bf16* VNT = (bf16*)(ws_ + WS_VNT); const float* rsc = (const float*)(ws_ + WS_RSC);
        const float sc = (MODE == 2) ? __builtin_bit_cast(float, __builtin_amdgcn_readfirstlane(((const unsigned*)(ws_ + WS_CTL))[CW_WSC + 9])) : (MODE == 1 ? 1.0f / 64.0f : 1.0f);
        const int b = u.pm >> 4;
        const int s0 = (u.pm & 15) * BM + wr * 64 + 4 * fq;
#pragma unroll
        for (int bj = 0; bj < 2; ++bj)
#pragma unroll
            for (int n = 0; n < 2; ++n) { const int cl = bj * HALF + wc * 32 + n * 16 + fr;
#pragma unroll
                for (int ai = 0; ai < 2; ++ai)
#pragma unroll
                    for (int m = 0; m < 4; ++m) { const int s = s0 + ai * HALF + m * 16; f32x4 v;
                        if constexpr (MODE == 2) { const v4i iv = __builtin_bit_cast(v4i, acc[ai][bj][m][n]); const f32x4 rq = *(const f32x4*)(rsc + b * SEQ + s);
                            v = (f32x4){(float)iv[0], (float)iv[1], (float)iv[2], (float)iv[3]} * rq * sc; }
                        else v = acc[ai][bj][m][n] * sc;
                        if (u.pn == 0 && bj == 0) {
                            bf16* p = KA + (size_t)(b * SEQ + s) * 128 + cl;
                            p[0] = (bf16)f2bf(v[0]); p[128] = (bf16)f2bf(v[1]); p[256] = (bf16)f2bf(v[2]); p[384] = (bf16)f2bf(v[3]);
                        } else {
                            bf16* p = (u.pn == 0) ? VAT + ((size_t)b * 128 + (cl - 128)) * SEQ + s : VNT + ((size_t)b * 1024 + (u.pn - 1) * BM + cl) * SEQ + s;
                            u32x2 w; w.x = pk2(v[0], v[1]); w.y = pk2(v[2], v[3]); *(u32x2*)p = w;
                        } } }
    }
};
template <int MODE> struct EpiProjTT {
    static constexpr bool PERM = false, TRANS = false, FP8 = false, I8 = (MODE == 2);
    bf16* OT; const float* bias; int ldt; float sc; const float* rsc;
    __device__ __forceinline__ void operator()(const f32x4 (&acc)[2][2][4][2], const Unit& u, int wr, int wc, int fr, int fq) const {
        const int r0 = u.pm * BM + wr * 64 + 4 * fq;
#pragma unroll
        for (int bj = 0; bj < 2; ++bj)
#pragma unroll
            for (int n = 0; n < 2; ++n) { const int col = u.pn * BM + bj * HALF + wc * 32 + n * 16 + fr; const float bv = bias[col];
                bf16* cp = OT + (size_t)col * ldt + r0;
#pragma unroll
                for (int ai = 0; ai < 2; ++ai)
#pragma unroll
                    for (int m = 0; m < 4; ++m) { f32x4 v;
                        if constexpr (MODE == 2) { const v4i iv = __builtin_bit_cast(v4i, acc[ai][bj][m][n]); const f32x4 rq = *(const f32x4*)(rsc + r0 + ai * HALF + m * 16);
                            v = (f32x4){(float)iv[0], (float)iv[1], (float)iv[2], (float)iv[3]} * rq * sc; }
                        else v = acc[ai][bj][m][n];
                        u32x2 w; w.x = pk2(v[0] + bv, v[1] + bv); w.y = pk2(v[2] + bv, v[3] + bv);
                        *(u32x2*)(cp + ai * HALF + m * 16) = w; } }
    }
};
typedef EpiProjTT<0> EpiProjT;
struct EpiFilt {
    static constexpr bool PERM = false, TRANS = false, FP8 = false, I8 = false;
    bf16* F;
    __device__ __forceinline__ void operator()(const f32x4 (&acc)[2][2][4][2], const Unit& u, int wr, int wc, int fr, int fq) const {
        const int t00 = u.pm * BM + wr * 64 + 4 * fq;
        const int colb = u.pn * BM + wc * 32 + fr;
#pragma unroll
        for (int ai = 0; ai < 2; ++ai)
#pragma unroll
            for (int m = 0; m < 4; ++m) { const int t0 = t00 + ai * HALF + m * 16; float tl[4];
#pragma unroll
                for (int j = 0; j < 4; ++j) tl[j] = (float)(t0 + j) * (-1.0f / 4095.0f);
#pragma unroll
                for (int bj = 0; bj < 2; ++bj)
#pragma unroll
                    for (int n = 0; n < 2; ++n) { const int col = colb + bj * HALF + n * 16; const int dir = col >> 12, o = (col >> 11) & 1, c = col & 2047;
                        const float adl = 3.0701134573253944f + (float)c * ((15.350567286626973f - 3.0701134573253944f) / 2047.0f);
                        bf16* cp = F + ((size_t)(o * 2048 + c) * 2 + dir) * 4096 + t0;
                        const f32x4 v = acc[ai][bj][m][n];
                        u32x2 w; w.x = pk2(v[0] * __expf(adl * tl[0]), v[1] * __expf(adl * tl[1])); w.y = pk2(v[2] * __expf(adl * tl[2]), v[3] * __expf(adl * tl[3])); *(u32x2*)cp = w; }
                asm volatile("" ::: "memory"); }
    }
};
}

#define XB_TMO      128
#define XB_XCNT(j)  (256  + 64 * (j))
#define XB_XSUB(j)  (1280 + 64 * (j))
#define XB_XGEN(j)  (2304 + 64 * (j))
#define XB_TOP      3328
#define XB_TOPGEN   3392
#define XCD_BAR_WORDS 3456
#define XB_SPIN_CAP (1u << 18)
__device__ __forceinline__ unsigned xb_ld(unsigned* p)              { return __hip_atomic_load(p, __ATOMIC_RELAXED, __HIP_MEMORY_SCOPE_AGENT); }
__device__ __forceinline__ unsigned xb_add(unsigned* p, unsigned v) { return __hip_atomic_fetch_add(p, v, __ATOMIC_RELAXED, __HIP_MEMORY_SCOPE_AGENT); }
__device__ __forceinline__ unsigned xb_xcc_id() { return (unsigned)__builtin_amdgcn_s_getreg((3 << 11) | 20) & 0xFu; }
#define XB_SPIN(cond, bar) do { unsigned _sp = 0; while (cond) { __builtin_amdgcn_s_sleep(1); \
    if ((++_sp & 255u) == 0u) { if (xb_ld(&(bar)[XB_TMO])) break; if (_sp > XB_SPIN_CAP) { atomicAdd(&(bar)[XB_TMO], 1u); break; } } } } while (0)
struct XcdBarrier { unsigned* bar; unsigned x; volatile LAS unsigned* st; };
__device__ __forceinline__ XcdBarrier xcd_barrier_post(unsigned* bar, volatile LAS unsigned* st) {
    XcdBarrier b; b.bar = bar; b.x = xb_xcc_id(); b.st = st;
    if (threadIdx.x == 0) (void)xb_add(&bar[XB_XCNT(b.x)], 1u);
    return b;
}
__device__ __forceinline__ void xcd_barrier_complete(unsigned* bar, unsigned x, unsigned& nloc, unsigned& nx) {
    const unsigned G = gridDim.x * gridDim.y * gridDim.z;
    unsigned sum, cnt, mine, sp = 0u;
    for (;;) {
        sum = 0u; cnt = 0u; mine = 0u;
#pragma unroll
        for (unsigned j = 0; j < 16; ++j) { const unsigned c = xb_ld(&bar[XB_XCNT(j)]); sum += c; cnt += (c > 0u) ? 1u : 0u; mine = (j == x) ? c : mine; }
        if (sum == G) break;
        __builtin_amdgcn_s_sleep(1);
        if ((++sp & 255u) == 0u) { if (xb_ld(&bar[XB_TMO])) break; if (sp > XB_SPIN_CAP) { atomicAdd(&bar[XB_TMO], 1u); break; } }
    }
    nloc = mine > 0u ? mine : 1u; nx = cnt > 0u ? cnt : 1u;
}
__device__ __forceinline__ void xcd_barrier(const XcdBarrier& b) {
    asm volatile("s_waitcnt vmcnt(0)" ::: "memory");
    __syncthreads();
    if (threadIdx.x == 0) {
        unsigned* bar = b.bar;
        __builtin_amdgcn_s_waitcnt(0);
        unsigned nloc = b.st[0], nx = b.st[1];
        if (nloc == 0u) { xcd_barrier_complete(bar, b.x, nloc, nx); b.st[0] = nloc; b.st[1] = nx; }
        const unsigned old = xb_add(&bar[XB_XSUB(b.x)], 1u);
        const unsigned gen = old / nloc;
        if (old + 1u == (gen + 1u) * nloc) {
            __builtin_amdgcn_fence(__ATOMIC_RELEASE, "agent");
            asm volatile("s_waitcnt vmcnt(0)" ::: "memory");
            const unsigned og = xb_add(&bar[XB_TOP], 1u);
            const unsigned tg = og / nx;
            if (og + 1u == (tg + 1u) * nx) xb_add(&bar[XB_TOPGEN], 1u);
            else XB_SPIN(xb_ld(&bar[XB_TOPGEN]) == tg, bar);
            __builtin_amdgcn_fence(__ATOMIC_ACQUIRE, "agent");
            xb_add(&bar[XB_XGEN(b.x)], 1u);
            asm volatile("s_waitcnt vmcnt(0)" ::: "memory");
        } else {
            XB_SPIN(xb_ld(&bar[XB_XGEN(b.x)]) == gen, bar);
            __builtin_amdgcn_fence(__ATOMIC_ACQUIRE, "agent");
            asm volatile("s_waitcnt vmcnt(0)" ::: "memory");
        }
    }
    __syncthreads();
}

struct Args { const float* in[32]; float* out; unsigned char* ws; int ph_lo, ph_hi; };
enum { I_X = 0, I_P, I_LN_MIX, I_LN_FFN, I_LN_PLE, I_FINAL, I_T5, I_W_AIN, I_W_AOUT, I_SINK, I_RPB, I_W_FG, I_W_FU, I_W_FD, I_W_HI, I_B_HI, I_W_HC, I_B_HC,
       I_W_F1, I_B_F1, I_W_F2, I_B_F2, I_FREQ, I_W_F3, I_HYB, I_W_HO, I_W_RT, I_W_EG, I_W_EU, I_W_ED, I_W_PP, I_W_PG };

__device__ __forceinline__ void cvt_item(const float* W, int K, int N, bf16* WT, int k0, int n0, int drow0, LAS float* scr, int lane) {
    float tv[32];
    const float* wp = W + (size_t)(k0 + (lane >> 5)) * N + n0 + (lane & 31);
#pragma unroll
    for (int i = 0; i < 32; ++i) tv[i] = __builtin_nontemporal_load(wp + (size_t)(2 * i) * N);
#pragma unroll
    for (int i = 0; i < 32; ++i) scr[(2 * i + (lane >> 5)) * 33 + (lane & 31)] = tv[i];
    LDS_WAIT(); asm volatile("" ::: "memory");
    const int c = lane & 7;
#pragma unroll
    for (int j = 0; j < 4; ++j) { const int n = (lane >> 3) + 8 * j; const LAS float* s = scr + (8 * c) * 33 + n;
        u32x4 o; o.x = pk2(s[0 * 33], s[1 * 33]); o.y = pk2(s[2 * 33], s[3 * 33]); o.z = pk2(s[4 * 33], s[5 * 33]); o.w = pk2(s[6 * 33], s[7 * 33]);
        __builtin_nontemporal_store(o, (u32x4*)(WT + (size_t)(drow0 + n) * K + k0 + 8 * c)); }
    LDS_WAIT(); asm volatile("" ::: "memory");
}
template <bool QI8 = false>
__device__ __forceinline__ void cvt_item8(const float* W, int K, int N, unsigned char* WT, int k0, int n0, int drow0, LAS float* scr, int lane, float qmul = 64.f) {
    float tv[64];
    const float* wp = W + (size_t)(k0 + (lane >> 5)) * N + n0 + (lane & 31);
#pragma unroll
    for (int i = 0; i < 64; ++i) tv[i] = __builtin_nontemporal_load(wp + (size_t)(2 * i) * N);
#pragma unroll
    for (int i = 0; i < 64; ++i) scr[(2 * i + (lane >> 5)) * 33 + (lane & 31)] = tv[i];
    LDS_WAIT(); asm volatile("" ::: "memory");
    const int c = lane & 7;
#pragma unroll
    for (int j = 0; j < 4; ++j) { const int n = (lane >> 3) + 8 * j; const LAS float* sp = scr + (16 * c) * 33 + n;
        u32x4 o;
        if constexpr (QI8) {
        o.x = pk4_i8(qmul * sp[0 * 33], qmul * sp[1 * 33], qmul * sp[2 * 33], qmul * sp[3 * 33]); o.y = pk4_i8(qmul * sp[4 * 33], qmul * sp[5 * 33], qmul * sp[6 * 33], qmul * sp[7 * 33]);
        o.z = pk4_i8(qmul * sp[8 * 33], qmul * sp[9 * 33], qmul * sp[10 * 33], qmul * sp[11 * 33]); o.w = pk4_i8(qmul * sp[12 * 33], qmul * sp[13 * 33], qmul * sp[14 * 33], qmul * sp[15 * 33]);
        } else {
        o.x = pk4_fp8(64.f * sp[0 * 33], 64.f * sp[1 * 33], 64.f * sp[2 * 33], 64.f * sp[3 * 33]); o.y = pk4_fp8(64.f * sp[4 * 33], 64.f * sp[5 * 33], 64.f * sp[6 * 33], 64.f * sp[7 * 33]);
        o.z = pk4_fp8(64.f * sp[8 * 33], 64.f * sp[9 * 33], 64.f * sp[10 * 33], 64.f * sp[11 * 33]); o.w = pk4_fp8(64.f * sp[12 * 33], 64.f * sp[13 * 33], 64.f * sp[14 * 33], 64.f * sp[15 * 33]);
        }
        __builtin_nontemporal_store(o, (u32x4*)(WT + (size_t)(drow0 + n) * K + k0 + 16 * c)); }
    LDS_WAIT(); asm volatile("" ::: "memory");
}
__device__ __forceinline__ void cvt_job8(const float* W, int K, int N, unsigned char* WT, int il, int item, LAS float* scr, int lane) {
    const int nblk = N / 32, kb = item / nblk, nb = item % nblk, n0 = 32 * nb;
    const int drow0 = il == 0 ? n0 : ((n0 >> 7) * 256 + (n0 & 127) + (il == 2 ? 128 : 0));
    cvt_item8(W, K, N, WT, 128 * kb, n0, drow0, scr, lane);
}
__device__ __forceinline__ void cvt_job_i8(const float* W, int K, int N, unsigned char* WT, int il, int item, LAS float* scr, int lane, float qmul) {
    const int nblk = N / 32, kb = item / nblk, nb = item % nblk, n0 = 32 * nb;
    const int drow0 = il == 0 ? n0 : ((n0 >> 7) * 256 + (n0 & 127) + (il == 2 ? 128 : 0));
    cvt_item8<true>(W, K, N, WT, 128 * kb, n0, drow0, scr, lane, qmul);
}
__device__ __forceinline__ void cvt_job(const float* W, int K, int N, bf16* WT, int il, int item, LAS float* scr, int lane) {
    const int nblk = N / 32, kb = item / nblk, nb = item % nblk, n0 = 32 * nb;
    const int drow0 = il == 0 ? n0 : ((n0 >> 7) * 256 + (n0 & 127) + (il == 2 ? 128 : 0));
    cvt_item(W, K, N, WT, 64 * kb, n0, drow0, scr, lane);
}

__device__ __forceinline__ void rms_row_bf16(const float* xrow, const float* gain, bf16* orow, int lane) {
    const f32x4* xr = (const f32x4*)xrow + lane;
    f32x4 v[8]; float s = 0.f;
#pragma unroll
    for (int j = 0; j < 8; ++j) { v[j] = xr[64 * j]; s += (v[j][0] * v[j][0] + v[j][1] * v[j][1]) + (v[j][2] * v[j][2] + v[j][3] * v[j][3]); }
    const float rstd = 1.0f / sqrtf(wave_sum(s) * (1.f / DM) + RMS_EPS);
    const f32x4* gr = (const f32x4*)gain + lane;
    u32x2* o8 = (u32x2*)orow + lane;
#pragma unroll
    for (int j = 0; j < 8; ++j) { const f32x4 g = gr[64 * j]; u32x2 w; w.x = pk2(v[j][0] * rstd * g[0], v[j][1] * rstd * g[1]); w.y = pk2(v[j][2] * rstd * g[2], v[j][3] * rstd * g[3]); o8[64 * j] = w; }
}
__device__ __forceinline__ void rms_row_fp8(const float* xrow, const float* gain, unsigned char* orow, int lane) {
    const f32x4* xr = (const f32x4*)xrow + lane;
    f32x4 v[8]; float s = 0.f;
#pragma unroll
    for (int j = 0; j < 8; ++j) { v[j] = xr[64 * j]; s += (v[j][0] * v[j][0] + v[j][1] * v[j][1]) + (v[j][2] * v[j][2] + v[j][3] * v[j][3]); }
    const float rstd = 1.0f / sqrtf(wave_sum(s) * (1.f / DM) + RMS_EPS);
    const f32x4* gr = (const f32x4*)gain + lane;
    unsigned* o4 = (unsigned*)orow + lane;
#pragma unroll
    for (int j = 0; j < 8; ++j) { const f32x4 g = gr[64 * j]; o4[64 * j] = pk4_fp8(v[j][0] * rstd * g[0], v[j][1] * rstd * g[1], v[j][2] * rstd * g[2], v[j][3] * rstd * g[3]); }
}
__device__ __forceinline__ void rms_row_i8(const float* xrow, const float* gain, unsigned char* orow, float* rsc, int lane) {
    const f32x4* xr = (const f32x4*)xrow + lane;
    f32x4 v[8]; float s = 0.f;
#pragma unroll
    for (int j = 0; j < 8; ++j) { v[j] = xr[64 * j]; s += (v[j][0] * v[j][0] + v[j][1] * v[j][1]) + (v[j][2] * v[j][2] + v[j][3] * v[j][3]); }
    const float rstd = 1.0f / sqrtf(wave_sum(s) * (1.f / DM) + RMS_EPS);
    const f32x4* gr = (const f32x4*)gain + lane;
    float mx = 0.f;
#pragma unroll
    for (int j = 0; j < 8; ++j) { const f32x4 g = gr[64 * j]; v[j] = v[j] * rstd * g; mx = fmaxf(mx, fmaxf(fmaxf(fabsf(v[j][0]), fabsf(v[j][1])), fmaxf(fabsf(v[j][2]), fabsf(v[j][3])))); }
    mx = fmaxf(wave_max(mx), 1e-20f);
    const float inv = 127.0f / mx;
    unsigned* o4 = (unsigned*)orow + lane;
#pragma unroll
    for (int j = 0; j < 8; ++j) o4[64 * j] = pk4_i8(v[j][0] * inv, v[j][1] * inv, v[j][2] * inv, v[j][3] * inv);
    if (lane == 0) *rsc = mx * (1.0f / 127.0f);
}
__device__ __forceinline__ void rms_row_f32(const float* xrow, const float* gain, float* orow, int lane) {
    const f32x4* xr = (const f32x4*)xrow + lane;
    f32x4 v[8]; float s = 0.f;
#pragma unroll
    for (int j = 0; j < 8; ++j) { v[j] = xr[64 * j]; s += (v[j][0] * v[j][0] + v[j][1] * v[j][1]) + (v[j][2] * v[j][2] + v[j][3] * v[j][3]); }
    const float rstd = 1.0f / sqrtf(wave_sum(s) * (1.f / DM) + RMS_EPS);
    const f32x4* gr = (const f32x4*)gain + lane;
    f32x4* o = (f32x4*)orow + lane;
#pragma unroll
    for (int j = 0; j < 8; ++j) { const f32x4 g = gr[64 * j]; o[64 * j] = v[j] * rstd * g; }
}

__device__ __forceinline__ int t5_bucket(int rel) {
    const int n = rel < 0 ? -rel : rel;
    int b;
    if (n < 8) b = n; else { const int m = (31 - __clz(n * n)) - 6; b = 8 + m; b = b > 15 ? 15 : b; }
    return (rel > 0 ? 16 : 0) + b;
}

constexpr int AA_KROW = 160, AA_VROW = 816;
constexpr int AA_K = 0, AA_V = 384 * AA_KROW, AA_TB = AA_V + 64 * AA_VROW, AA_END = AA_TB + 4 * 288 * 4;
static_assert(AA_END <= RING_BYTES, "attention LDS");
__device__ __forceinline__ void attn_a_unit(int unit, int tid, int wave, int lane, LAS unsigned char* lds, const bf16* QA, const bf16* KA, const bf16* VAT, bf16* AO, const float* t5, const float* sinkp) {
    const int b = unit >> 7, nb = (unit >> 2) & 31, kvh = (unit >> 1) & 1, half = unit & 1;
    const int h4 = wave >> 1, head = kvh * 8 + half * 4 + h4;
    const int r = lane & 15, g = lane >> 4;
    __syncthreads();
    {
        const u32x4 z4 = (u32x4){0u, 0u, 0u, 0u};
#pragma unroll
        for (int i = 0; i < 6; ++i) { const int c = tid + 512 * i, row = c >> 3, part = c & 7; const int kpos = 128 * (nb - 1) + row;
            const u32x4 v = (kpos >= 0 && kpos < SEQ) ? *(const u32x4*)(KA + (size_t)(b * SEQ + kpos) * 128 + kvh * 64 + part * 8) : z4;
            *(LAS u32x4*)(lds + AA_K + row * AA_KROW + part * 16) = v; }
#pragma unroll
        for (int i = 0; i < 7; ++i) { const int c = tid + 512 * i; if (c < 64 * 50) { const int d = c / 50, part = c % 50; const int kpos = 128 * (nb - 1) + 8 * part;
            const u32x4 v = (part < 48 && kpos >= 0 && kpos < SEQ) ? *(const u32x4*)(VAT + ((size_t)b * 128 + kvh * 64 + d) * SEQ + kpos) : z4;
            *(LAS u32x4*)(lds + AA_V + d * AA_VROW + part * 16) = v; } }
        for (int idx = tid; idx < 4 * 288; idx += 512) { const int hh = idx / 288, rel = idx % 288 - 143;
            ((LAS float*)(lds + AA_TB))[idx] = t5[t5_bucket(rel) * 16 + kvh * 8 + half * 4 + hh]; }
    }
    __syncthreads();
    const float sink = sinkp[head];
    const LAS float* tb = (const LAS float*)(lds + AA_TB) + h4 * 288 + 143;
#pragma unroll 1
    for (int qt = 0; qt < 4; ++qt) {
        const int qi0 = (wave & 1) * 64 + qt * 16, q16 = qi0 >> 4;
        const bf16* qp = QA + (size_t)(b * SEQ + nb * 128 + qi0 + r) * 1024 + head * 64 + 8 * g;
        const bf16x8 qf0 = *(const bf16x8*)qp, qf1 = *(const bf16x8*)(qp + 32);
        f32x4 s[18];
        float mx = -1e30f;
        const LAS unsigned char* kbase = lds + AA_K + (16 * q16 + r) * AA_KROW + 16 * g;
#pragma unroll
        for (int tt = 0; tt < 17; ++tt) {
            const int kp0 = 128 * (nb - 1) + 16 * (q16 + tt);
            const bool inr = (kp0 >= 0) && (kp0 < SEQ);
            const bf16x8 kf0 = *(const LAS bf16x8*)(kbase + tt * 16 * AA_KROW), kf1 = *(const LAS bf16x8*)(kbase + tt * 16 * AA_KROW + 64);
            f32x4 a = (f32x4){0.f, 0.f, 0.f, 0.f};
            a = __builtin_amdgcn_mfma_f32_16x16x32_bf16(kf0, qf0, a, 0, 0, 0);
            a = __builtin_amdgcn_mfma_f32_16x16x32_bf16(kf1, qf1, a, 0, 0, 0);
#pragma unroll
            for (int j = 0; j < 4; ++j) {
                const int rel = 16 * tt + 4 * g + j - 128 - r;
                const bool ok = inr && ((tt == 0) ? (rel >= -128) : ((tt == 16) ? (rel <= 128) : true));
                const float v = ok ? a[j] * 0.125f + tb[rel] : -1e30f;
                a[j] = v; mx = fmaxf(mx, v);
            }
            s[tt] = a;
        }
        s[17] = (f32x4){-1e30f, -1e30f, -1e30f, -1e30f};
        mx = fmaxf(mx, __shfl_xor(mx, 16)); mx = fmaxf(mx, __shfl_xor(mx, 32));
        const float m = fmaxf(mx, sink);
        float sum = 0.f;
        unsigned pw[18][2];
#pragma unroll
        for (int tt = 0; tt < 18; ++tt) {
            float p[4];
#pragma unroll
            for (int j = 0; j < 4; ++j) { p[j] = (s[tt][j] > -1e29f) ? __expf(s[tt][j] - m) : 0.f; sum += p[j]; }
            pw[tt][0] = pk2(p[0], p[1]); pw[tt][1] = pk2(p[2], p[3]);
        }
        sum += __shfl_xor(sum, 16); sum += __shfl_xor(sum, 32);
        const float inv = 1.0f / (sum + __expf(sink - m));
        f32x4 o[4];
#pragma unroll
        for (int dt = 0; dt < 4; ++dt) o[dt] = (f32x4){0.f, 0.f, 0.f, 0.f};
        const LAS unsigned char* vbase = lds + AA_V + r * AA_VROW + 2 * (16 * q16 + 4 * g);
#pragma unroll
        for (int pr = 0; pr < 9; ++pr) {
            union { bf16x8 v; unsigned u[4]; } pf; pf.u[0] = pw[2 * pr][0]; pf.u[1] = pw[2 * pr][1]; pf.u[2] = pw[2 * pr + 1][0]; pf.u[3] = pw[2 * pr + 1][1];
#pragma unroll
            for (int dt = 0; dt < 4; ++dt) {
                const LAS unsigned char* vp = vbase + dt * 16 * AA_VROW + 64 * pr;
                union { bf16x8 v; u32x2 hh[2]; } vf; vf.hh[0] = *(const LAS u32x2*)vp; vf.hh[1] = *(const LAS u32x2*)(vp + 32);
                o[dt] = __builtin_amdgcn_mfma_f32_16x16x32_bf16(vf.v, pf.v, o[dt], 0, 0, 0);
            }
        }
        unsigned char* op = (unsigned char*)AO + (size_t)(b * SEQ + nb * 128 + qi0 + r) * DM + head * 64 + 4 * g;
#pragma unroll
        for (int dt = 0; dt < 4; ++dt) *(unsigned*)(op + 16 * dt) = pk4_fp8(o[dt][0] * inv, o[dt][1] * inv, o[dt][2] * inv, o[dt][3] * inv);
    }
}

constexpr int AB_K = 0, AB_VROW = 1168, AB_V = 576 * 128, AB_T = AB_V + 64 * AB_VROW, AB_END = AB_T + 2048;
static_assert(AB_END <= MISC_OFF, "attention B LDS");
__device__ __forceinline__ void attn_b_unit(int unit, int tid, int wave, int lane, LAS unsigned char* lds, const bf16* QN, const bf16* KN, const bf16* VNT, bf16* AO, const float* rpb) {
    const int b = unit >> 9, rw0 = ((unit >> 4) & 31) * 2, h = unit & 15;
    const int rs0 = rw0 - 4 < 0 ? 0 : (rw0 - 4 > 56 ? 56 : rw0 - 4);
    const int nkeys = (64 - rs0 < 9 ? 64 - rs0 : 9) * 64;
    __syncthreads();
    {
        const u32x4 z4 = (u32x4){0u, 0u, 0u, 0u};
#pragma unroll
        for (int i = 0; i < 9; ++i) { const int c = tid + 512 * i, key = c >> 3, ch = c & 7;
            const u32x4 v = (key < nkeys) ? *(const u32x4*)(KN + (size_t)(b * SEQ + rs0 * 64 + key) * 1024 + h * 64 + ch * 8) : z4;
            *(LAS u32x4*)(lds + AB_K + key * 128 + ((ch ^ (key & 7)) * 16)) = v; }
#pragma unroll
        for (int i = 0; i < 9; ++i) { const int c = tid + 512 * i, d = c / 72, part = c % 72;
            const u32x4 v = (part * 8 < nkeys) ? *(const u32x4*)(VNT + ((size_t)b * 1024 + h * 64 + d) * SEQ + rs0 * 64 + part * 8) : z4;
            *(LAS u32x4*)(lds + AB_V + d * AB_VROW + part * 16) = v; }
        if (tid < 465) ((LAS float*)(lds + AB_T))[tid] = rpb[(size_t)h * 465 + tid];
    }
    __syncthreads();
    const int rw = rw0 + (wave >> 2), jq = wave & 3;
    const int r = lane & 15, g = lane >> 4;
    const int cb = (jq == 0) ? 0 : (jq == 1 ? 8 : (jq == 2 ? 24 : 32));
    const int rs = rw - 4 < 0 ? 0 : (rw - 4 > 56 ? 56 : rw - 4);
    const int c = 16 * jq + r;
    const int cs = c - 8 < 0 ? 0 : (c - 8 > 48 ? 48 : c - 8);
    const bf16* qp = QN + (size_t)(b * SEQ + rw * 64 + c) * 1024 + h * 64 + 8 * g;
    const bf16x8 qf0 = *(const bf16x8*)qp, qf1 = *(const bf16x8*)(qp + 32);
    const LAS float* rpt = (const LAS float*)(lds + AB_T);
    f32x4 s[16];
    float mx = -1e30f;
    const int kl0 = (rs - rs0) * 64 + cb + r;
#pragma unroll
    for (int kt = 0; kt < 16; ++kt) { const int kr = kt >> 1, ch = kt & 1; const int kl = kl0 + kr * 64 + 16 * ch; const int sw = kl & 7;
        const LAS unsigned char* kp = lds + AB_K + kl * 128;
        const bf16x8 kf0 = *(const LAS bf16x8*)(kp + ((g ^ sw) * 16)), kf1 = *(const LAS bf16x8*)(kp + (((g + 4) ^ sw) * 16));
        f32x4 a = (f32x4){0.f, 0.f, 0.f, 0.f};
        a = __builtin_amdgcn_mfma_f32_16x16x32_bf16(kf0, qf0, a, 0, 0, 0);
        a = __builtin_amdgcn_mfma_f32_16x16x32_bf16(kf1, qf1, a, 0, 0, 0);
        const int roff = (rs + kr) - rw + 7;
#pragma unroll
        for (int j = 0; j < 4; ++j) {
            const int kc = cb + 16 * ch + 4 * g + j;
            const bool ok = (kc >= cs) && (kc < cs + 16);
            int coff = kc - c + 15; coff = coff < 0 ? 0 : (coff > 30 ? 30 : coff);
            const float v = ok ? a[j] * 0.125f + rpt[roff * 31 + coff] : -1e30f;
            a[j] = v; mx = fmaxf(mx, v);
        }
        s[kt] = a; }
    mx = fmaxf(mx, __shfl_xor(mx, 16)); mx = fmaxf(mx, __shfl_xor(mx, 32));
    float sum = 0.f;
    unsigned pw[16][2];
#pragma unroll
    for (int kt = 0; kt < 16; ++kt) {
        float p[4];
#pragma unroll
        for (int j = 0; j < 4; ++j) { p[j] = (s[kt][j] > -1e29f) ? __expf(s[kt][j] - mx) : 0.f; sum += p[j]; }
        pw[kt][0] = pk2(p[0], p[1]); pw[kt][1] = pk2(p[2], p[3]);
    }
    sum += __shfl_xor(sum, 16); sum += __shfl_xor(sum, 32);
    const float inv = 1.0f / sum;
    f32x4 o[4];
#pragma unroll
    for (int dt = 0; dt < 4; ++dt) o[dt] = (f32x4){0.f, 0.f, 0.f, 0.f};
    const LAS unsigned char* vbase = lds + AB_V + r * AB_VROW + 2 * ((rs - rs0) * 64 + cb + 4 * g);
#pragma unroll
    for (int kr = 0; kr < 8; ++kr) {
        union { bf16x8 v; unsigned u[4]; } pf; pf.u[0] = pw[2 * kr][0]; pf.u[1] = pw[2 * kr][1]; pf.u[2] = pw[2 * kr + 1][0]; pf.u[3] = pw[2 * kr + 1][1];
#pragma unroll
        for (int dt = 0; dt < 4; ++dt) { const LAS unsigned char* vp = vbase + dt * 16 * AB_VROW + kr * 128;
            union { bf16x8 v; u32x2 hh[2]; } vf; vf.hh[0] = *(const LAS u32x2*)vp; vf.hh[1] = *(const LAS u32x2*)(vp + 32);
            o[dt] = __builtin_amdgcn_mfma_f32_16x16x32_bf16(vf.v, pf.v, o[dt], 0, 0, 0); }
    }
    unsigned char* op = (unsigned char*)AO + (size_t)(b * SEQ + rw * 64 + c) * DM + 1024 + h * 64 + 4 * g;
#pragma unroll
    for (int dt = 0; dt < 4; ++dt) *(unsigned*)(op + 16 * dt) = pk4_fp8(o[dt][0] * inv, o[dt][1] * inv, o[dt][2] * inv, o[dt][3] * inv);
}

__device__ __forceinline__ void hy_hidden1(int item, int lane, const float* fw1, const float* fb1, const float* fr, float* H1) {
    const int t = (item >> 3) * 64 + lane, j0 = (item & 7) * 8;
    float zv[33];
    zv[0] = (float)t * (1.0f / 4095.0f);
    const float w = (6.283185307179586f / 4096.0f) * (float)t;
#pragma unroll
    for (int k = 0; k < 16; ++k) { const float f = 1e-4f + (float)k * ((15.0f - 1e-4f) / 15.0f); const float a = f * w; zv[1 + k] = cosf(a); zv[17 + k] = -sinf(a); }
    float o[8];
#pragma unroll
    for (int jj = 0; jj < 8; ++jj) { const int j = j0 + jj; float sacc = fb1[j];
#pragma unroll
        for (int m = 0; m < 33; ++m) sacc += zv[m] * fw1[m * 64 + j];
        o[jj] = sinf(fr[j] * sacc); }
    f32x4* dst = (f32x4*)(H1 + (size_t)t * 64 + j0); dst[0] = (f32x4){o[0], o[1], o[2], o[3]}; dst[1] = (f32x4){o[4], o[5], o[6], o[7]};
}
__device__ __forceinline__ void hy_hidden2(int item, int lane, const float* fw2, const float* fb2, const float* fr, const float* H1, bf16* AF) {
    const int t = (item >> 3) * 64 + lane, j0 = (item & 7) * 8;
    float h1[64];
    const f32x4* src = (const f32x4*)(H1 + (size_t)t * 64);
#pragma unroll
    for (int q = 0; q < 16; ++q) { const f32x4 v = src[q]; h1[4 * q] = v[0]; h1[4 * q + 1] = v[1]; h1[4 * q + 2] = v[2]; h1[4 * q + 3] = v[3]; }
    float o[8];
#pragma unroll
    for (int jj = 0; jj < 8; ++jj) { const int j = j0 + jj; float sacc = fb2[j];
#pragma unroll
        for (int m = 0; m < 64; ++m) sacc += h1[m] * fw2[m * 64 + j];
        o[jj] = sinf(fr[j] * sacc); }
    bf16* orow = AF + (size_t)t * 256;
    u32x4 w; w.x = pk2(o[0], o[1]); w.y = pk2(o[2], o[3]); w.z = pk2(o[4], o[5]); w.w = pk2(o[6], o[7]);
    *(u32x4*)(orow + j0) = w;
    const u32x4 z4 = (u32x4){0u, 0u, 0u, 0u};
#pragma unroll
    for (int i = 0; i < 3; ++i) *(u32x4*)(orow + 64 + 8 * ((item & 7) * 3 + i)) = z4;
}

constexpr int CV_ZROW = 160;
constexpr int CV_HW = 4160;
constexpr int CV_F = 2 * 64 * CV_ZROW;
constexpr int CV_ZERO = CV_F + 2 * CV_HW * 2;
constexpr int CV_PAIR = CV_ZERO + 128;
static_assert(4 * CV_PAIR <= MISC_OFF, "conv LDS");
__device__ __forceinline__ u32x4 conv_fchunk(const bf16* fw, const bf16* bw, int Q) {
    u32x4 o = (u32x4){0u, 0u, 0u, 0u};
    if (Q < 512) {
        const u32x4 r1 = *(const u32x4*)(fw + 4088 - 8 * Q);
        const unsigned n0 = (Q > 0) ? *(const unsigned*)(fw + 4096 - 8 * Q) : 0u;
        o.x = (n0 & 0xffffu) | (r1.w & 0xffff0000u); o.y = (r1.w & 0xffffu) | (r1.z & 0xffff0000u); o.z = (r1.z & 0xffffu) | (r1.y & 0xffff0000u); o.w = (r1.y & 0xffffu) | (r1.x & 0xffff0000u);
    } else if (Q < 1024) {
        o = *(const u32x4*)(bw + 8 * (Q - 512));
        if (Q == 512) { const unsigned c0 = f2bf(bf2f(fw[0]) + bflo(o.x)); o.x = (o.x & 0xffff0000u) | c0; }
    }
    return o;
}
__device__ __forceinline__ void hyena_conv_unit(int unit, int wave, int lane, LAS unsigned char* lds, const bf16* PROJT, const bf16* FILT, const float* cw, const float* cbias, const float* fbias, bf16* ZFT) {
    const int pair = wave >> 1, b = wave & 1, c = unit * 4 + pair;
    LAS unsigned char* pb = lds + pair * CV_PAIR;
    LAS unsigned char* zb = pb + b * (64 * CV_ZROW);
    LAS unsigned char* fc = pb + CV_F;
    LAS unsigned char* zero_p = pb + CV_ZERO;
    const int r = lane & 15, g = lane >> 4;
    if (b == 0 && lane < 32) ((LAS unsigned*)zero_p)[lane] = 0u;
    {
        const int f = 4096 + c;
        const float w0 = cw[f], w1 = cw[6144 + f], w2 = cw[2 * 6144 + f], cb = cbias[f];
        const bf16* src = PROJT + (size_t)f * NTOK + b * SEQ + lane * 64;
        float prev = (lane == 0) ? 0.f : bf2f(src[-1]);
        const float last = (lane == 63) ? 0.f : bf2f(src[64]);
#pragma unroll
        for (int i = 0; i < 8; ++i) {
            const u32x4 raw = *(const u32x4*)(src + 8 * i);
            const u32x4 nxt = (i < 7) ? *(const u32x4*)(src + 8 * i + 8) : raw;
            float v[10]; v[0] = prev;
            v[1] = bflo(raw.x); v[2] = bfhi(raw.x); v[3] = bflo(raw.y); v[4] = bfhi(raw.y); v[5] = bflo(raw.z); v[6] = bfhi(raw.z); v[7] = bflo(raw.w); v[8] = bfhi(raw.w);
            v[9] = (i < 7) ? bflo(nxt.x) : last;
            float o[8];
#pragma unroll
            for (int k = 0; k < 8; ++k) o[k] = w0 * v[k] + w1 * v[k + 1] + w2 * v[k + 2] + cb;
            u32x4 w; w.x = pk2(o[0], o[1]); w.y = pk2(o[2], o[3]); w.z = pk2(o[4], o[5]); w.w = pk2(o[6], o[7]);
            *(LAS u32x4*)(zb + lane * CV_ZROW + 16 * i) = w;
            prev = v[8];
        }
    }
    const int a_lane = (r & 1) * (CV_HW * 2) + 2 * (8 * g - r - (r & 1));
#pragma unroll 1
    for (int o = 0; o < 2; ++o) {
        const bf16* fw = FILT + ((size_t)(o * 2048 + c) * 2) * 4096; const bf16* bw = fw + 4096;
        f32x4 acc[4][4];
#pragma unroll
        for (int m = 0; m < 4; ++m)
#pragma unroll
            for (int n = 0; n < 4; ++n) acc[m][n] = (f32x4){0.f, 0.f, 0.f, 0.f};
        bf16x8 O2, O3, NC[4];
        union FragW { bf16x8 v; unsigned w[4]; };
#define CV_STAGE(QB) do { __syncthreads(); \
            _Pragma("unroll 1") for (int q = b * 64 + lane; q < CV_HW / 8; q += 128) { const u32x4 c0 = conv_fchunk(fw, bw, (QB) + q), c1 = conv_fchunk(fw, bw, (QB) + q + 1); \
                u32x4 s1; s1.x = __builtin_amdgcn_alignbit(c0.y, c0.x, 16); s1.y = __builtin_amdgcn_alignbit(c0.z, c0.y, 16); s1.z = __builtin_amdgcn_alignbit(c0.w, c0.z, 16); s1.w = __builtin_amdgcn_alignbit(c1.x, c0.w, 16); \
                *(LAS u32x4*)(fc + 16 * q) = c0; *(LAS u32x4*)(fc + CV_HW * 2 + 16 * q) = s1; } \
            __syncthreads(); } while (0)
#define CV_LOADA(dst, u, WB) do { const volatile LAS unsigned* _p = (const volatile LAS unsigned*)(fc + a_lane + 2 * (4096 - (WB) - 16 * (u))); FragW _f; _f.w[0] = _p[0]; _f.w[1] = _p[1]; _f.w[2] = _p[2]; _f.w[3] = _p[3]; dst = _f.v; } while (0)
#define CV_SEG(NLO, NHI, D0, D1, WB) _Pragma("unroll 1") for (int d = (D0); d <= (D1); ++d) { \
            bf16x8 Bf[4][2]; \
            _Pragma("unroll") for (int n = (NLO); n <= (NHI); ++n) { const int row = 16 * n + r - d; const bool ok = (unsigned)row < 64u; \
                const LAS unsigned char* bp = ok ? (zb + row * CV_ZROW + 16 * g) : zero_p; Bf[n][1] = *(const LAS bf16x8*)(bp + 64); Bf[n][0] = *(const LAS bf16x8*)bp; } \
            CV_LOADA(NC[0], 4 * d, WB); CV_LOADA(NC[1], 4 * d + 1, WB); CV_LOADA(NC[2], 4 * d + 2, WB); CV_LOADA(NC[3], 4 * d + 3, WB); \
            __builtin_amdgcn_s_setprio(1); \
            _Pragma("unroll") for (int n = (NLO); n <= (NHI); ++n) { acc[0][n] = __builtin_amdgcn_mfma_f32_16x16x32_bf16(O2, Bf[n][1], acc[0][n], 0, 0, 0); acc[1][n] = __builtin_amdgcn_mfma_f32_16x16x32_bf16(O3, Bf[n][1], acc[1][n], 0, 0, 0); } \
            _Pragma("unroll") for (int n = (NLO); n <= (NHI); ++n) { acc[2][n] = __builtin_amdgcn_mfma_f32_16x16x32_bf16(NC[0], Bf[n][1], acc[2][n], 0, 0, 0); acc[3][n] = __builtin_amdgcn_mfma_f32_16x16x32_bf16(NC[1], Bf[n][1], acc[3][n], 0, 0, 0); } \
            _Pragma("unroll") for (int m = 0; m < 4; ++m) _Pragma("unroll") for (int n = (NLO); n <= (NHI); ++n) acc[m][n] = __builtin_amdgcn_mfma_f32_16x16x32_bf16(NC[m], Bf[n][0], acc[m][n], 0, 0, 0); \
            __builtin_amdgcn_s_setprio(0); O2 = NC[2]; O3 = NC[3]; }
        CV_STAGE(512);
        CV_LOADA(O2, 4 * (-64) + 2, 4096); CV_LOADA(O3, 4 * (-64) + 3, 4096);
        CV_SEG(0, 0, -63, -48, 4096)
        CV_SEG(0, 1, -47, -32, 4096)
        CV_SEG(0, 2, -31, -16, 4096)
        CV_SEG(0, 3, -15, -1, 4096)
        CV_STAGE(0);
        CV_SEG(0, 3, 0, 15, 0)
        CV_SEG(1, 3, 16, 31, 0)
        CV_SEG(2, 3, 32, 47, 0)
        CV_SEG(3, 3, 48, 63, 0)
#undef CV_SEG
#undef CV_LOADA
#undef CV_STAGE
        {
            const int fx = (o == 0) ? c : 2048 + c;
            const float w0 = cw[fx], w1 = cw[6144 + fx], w2 = cw[2 * 6144 + fx], cbx = cbias[fx], fb = fbias[o * 2048 + c];
            const bf16* xs = PROJT + (size_t)fx * NTOK + b * SEQ;
#pragma unroll
            for (int n = 0; n < 4; ++n)
#pragma unroll
                for (int m = 0; m < 4; ++m) {
                    const int t = 64 * (16 * n + r) + 16 * m + 4 * g;
                    const u32x2 xr = *(const u32x2*)(xs + t);
                    float xv[6]; xv[0] = (t > 0) ? bf2f(xs[t - 1]) : 0.f; xv[1] = bflo(xr.x); xv[2] = bfhi(xr.x); xv[3] = bflo(xr.y); xv[4] = bfhi(xr.y); xv[5] = (t + 4 < SEQ) ? bf2f(xs[t + 4]) : 0.f;
                    LAS u32x2* zp = (LAS u32x2*)(zb + (16 * n + r) * CV_ZROW + 2 * (16 * m + 4 * g));
                    const u32x2 zr = *zp; float zo[4]; zo[0] = bflo(zr.x); zo[1] = bfhi(zr.x); zo[2] = bflo(zr.y); zo[3] = bfhi(zr.y);
                    float v[4];
#pragma unroll
                    for (int j = 0; j < 4; ++j) { const float gate = w0 * xv[j] + w1 * xv[j + 1] + w2 * xv[j + 2] + cbx; v[j] = gate * (acc[m][n][j] + zo[j] * fb); }
                    u32x2 w; w.x = pk2(v[0], v[1]); w.y = pk2(v[2], v[3]); *zp = w;
                }
        }
        LDS_WAIT(); asm volatile("" ::: "memory");
    }
    {
        bf16* dst = ZFT + (size_t)c * NTOK + b * SEQ + lane * 64;
#pragma unroll
        for (int i = 0; i < 8; ++i) *(u32x4*)(dst + 8 * i) = *(const LAS u32x4*)(zb + lane * CV_ZROW + 16 * i);
    }
    LDS_WAIT(); asm volatile("" ::: "memory");
}

__device__ __forceinline__ void transpose_tile(int tile, int lane, LAS unsigned short* tl, const bf16* ZFT, bf16* ZF) {
    const int c0 = (tile & 31) * 64, t0 = (tile >> 5) * 64;
    const bf16* src = ZFT + (size_t)(c0 + lane) * NTOK + t0;
#pragma unroll
    for (int i = 0; i < 8; ++i) { const u32x4 v = *(const u32x4*)(src + 8 * i); LAS unsigned* p = (LAS unsigned*)(tl + lane * 66 + 8 * i); p[0] = v.x; p[1] = v.y; p[2] = v.z; p[3] = v.w; }
    LDS_WAIT(); asm volatile("" ::: "memory");
    const int cg = lane & 7;
#pragma unroll
    for (int j = 0; j < 8; ++j) { const int tt = (lane >> 3) + 8 * j; const LAS unsigned short* p = tl + (8 * cg) * 66 + tt;
        u32x4 w; w.x = (unsigned)p[0] | ((unsigned)p[66] << 16); w.y = (unsigned)p[2 * 66] | ((unsigned)p[3 * 66] << 16); w.z = (unsigned)p[4 * 66] | ((unsigned)p[5 * 66] << 16); w.w = (unsigned)p[6 * 66] | ((unsigned)p[7 * 66] << 16);
        *(u32x4*)(ZF + (size_t)(t0 + tt) * DM + c0 + 8 * cg) = w; }
    LDS_WAIT(); asm volatile("" ::: "memory");
}


__device__ __forceinline__ void router_token(int m, int lane, const float* H, const float* gain, const float* wr, bf16* HN, unsigned* ctl, LAS unsigned* lhist) {
    const f32x4* xr = (const f32x4*)(H + (size_t)m * DM) + lane;
    f32x4 v[8]; float ss = 0.f;
#pragma unroll
    for (int j = 0; j < 8; ++j) { v[j] = xr[64 * j]; ss += (v[j][0] * v[j][0] + v[j][1] * v[j][1]) + (v[j][2] * v[j][2] + v[j][3] * v[j][3]); }
    const float rstd = 1.0f / sqrtf(wave_sum(ss) * (1.f / DM) + RMS_EPS);
    const f32x4* gr = (const f32x4*)gain + lane;
    unsigned* o8 = (unsigned*)((unsigned char*)HN + (size_t)m * DM) + lane;
    float lg[8];
#pragma unroll
    for (int e = 0; e < 8; ++e) lg[e] = 0.f;
#pragma unroll
    for (int j = 0; j < 8; ++j) { const f32x4 g = gr[64 * j]; f32x4 hn = v[j] * rstd * g;
        o8[64 * j] = pk4_fp8(hn[0], hn[1], hn[2], hn[3]);
        const f32x4* wp = (const f32x4*)(wr + (size_t)(4 * (lane + 64 * j)) * 8);
#pragma unroll
        for (int i = 0; i < 4; ++i) { const f32x4 wa = wp[2 * i], wb = wp[2 * i + 1];
            lg[0] += hn[i] * wa[0]; lg[1] += hn[i] * wa[1]; lg[2] += hn[i] * wa[2]; lg[3] += hn[i] * wa[3];
            lg[4] += hn[i] * wb[0]; lg[5] += hn[i] * wb[1]; lg[6] += hn[i] * wb[2]; lg[7] += hn[i] * wb[3]; } }
#pragma unroll
    for (int e = 0; e < 8; ++e) lg[e] = wave_sum(lg[e]);
    int i1 = 0; float v1 = lg[0];
#pragma unroll
    for (int e = 1; e < 8; ++e) if (lg[e] > v1) { v1 = lg[e]; i1 = e; }
    int i2 = -1; float v2 = -3.0e38f;
#pragma unroll
    for (int e = 0; e < 8; ++e) if (e != i1 && lg[e] > v2) { v2 = lg[e]; i2 = e; }
    const float g2 = 1.0f / (1.0f + __expf(v1 - v2)), g1 = 1.0f - g2;
    if (lane == 0) {
        ctl[CW_TOKE + 2 * m] = (unsigned)i1; ctl[CW_TOKE + 2 * m + 1] = (unsigned)i2;
        ctl[CW_TOKG + 2 * m] = __builtin_bit_cast(unsigned, g1); ctl[CW_TOKG + 2 * m + 1] = __builtin_bit_cast(unsigned, g2);
        atomicAdd((unsigned*)&lhist[i1], 1u); atomicAdd((unsigned*)&lhist[i2], 1u);
    }
}

__device__ __forceinline__ int fresh_tid() { int t = threadIdx.x; asm volatile("" : "+v"(t)); return t; }

__global__ void __launch_bounds__(NTHR, 2) fwd_kernel(Args args) {
    extern __shared__ __attribute__((aligned(16))) unsigned char lds_raw[];
    LAS unsigned char* lds = (LAS unsigned char*)lds_raw;
    volatile LAS unsigned* MISC = (volatile LAS unsigned*)(lds + MISC_OFF);
    const int tid = threadIdx.x, lane = tid & 63, wave = __builtin_amdgcn_readfirstlane(tid >> 6);
    const int G = gridDim.x, bid = blockIdx.x;
    const int gw = bid * NWAVES + wave, NGW = G * NWAVES;
    unsigned char* ws = args.ws;
    unsigned* ctl = (unsigned*)(ws + WS_CTL);
    for (int u = tid; u < (LDS_BYTES - MISC_OFF) / 4; u += NTHR) ((LAS unsigned*)(lds + MISC_OFF))[u] = 0u;
    __syncthreads();
#if MK_ONE_LAUNCH
    XcdBarrier bar = xcd_barrier_post(ctl + CW_BAR, MISC + 8);
#define GRID_BAR() xcd_barrier(bar)
#else
#define GRID_BAR() do { } while (0)
#endif
    const int lo = args.ph_lo, hi = args.ph_hi;
#define IN(k) (lo <= (k) && (k) < hi && ((k) <= LAST_PHASE || (k) == 20))
#define SEAM(k) do { if (IN(k) && IN((k) + 1)) GRID_BAR(); } while (0)

    const float* x = args.in[I_X];
    float* H = (float*)(ws + WS_H);
    bf16* HN = (bf16*)(ws + WS_HN);
    bf16* W_QK = (bf16*)(ws + WS_W_QK); bf16* W_V = (bf16*)(ws + WS_W_V); bf16* W_AO = (bf16*)(ws + WS_W_AO);
    bf16* W_GU = (bf16*)(ws + WS_W_GU); bf16* W_FD = (bf16*)(ws + WS_W_FD); bf16* W_PG = (bf16*)(ws + WS_W_PG); bf16* W_PP = (bf16*)(ws + WS_W_PP);
    bf16* W_HI = (bf16*)(ws + WS_W_HI); bf16* W_HO = (bf16*)(ws + WS_W_HO); bf16* W_EGU = (bf16*)(ws + WS_W_EGU); bf16* W_ED = (bf16*)(ws + WS_W_ED);
    bf16* PP = (bf16*)(ws + WS_PP); bf16* PB = (bf16*)(ws + WS_PB);
    bf16* QA = (bf16*)(ws + WS_QA); bf16* QN = (bf16*)(ws + WS_QN); bf16* KN = (bf16*)(ws + WS_KN); bf16* KA = (bf16*)(ws + WS_KA);
    bf16* FILT = (bf16*)(ws + WS_FILT); bf16* AF = (bf16*)(ws + WS_AF); bf16* BF = (bf16*)(ws + WS_BF);
    bf16* PROJT = (bf16*)(ws + WS_PROJT); bf16* ZFT = (bf16*)(ws + WS_ZFT); bf16* ZF = (bf16*)(ws + WS_ZF);
    bf16* XS = (bf16*)(ws + WS_XS); bf16* HMID = (bf16*)(ws + WS_HMID); float* Y = (float*)(ws + WS_Y);
    bf16* VAT = (bf16*)(ws + WS_VAT); bf16* VNT = (bf16*)(ws + WS_VNT); bf16* AO = (bf16*)(ws + WS_AO); bf16* MID = (bf16*)(ws + WS_MID);

    if (IN(-1)) { const int tid = fresh_tid(), lane = tid & 63;
        constexpr int NQM = 5;
        for (int m = bid; m < NQM; m += G) {
            const float* W = (m == 0) ? args.in[I_W_FG] : (m == 1) ? args.in[I_W_FU] : (m == 2) ? args.in[I_W_HI] : (m == 3) ? args.in[I_W_PG] : args.in[I_W_AIN];
            const int n16 = 16 * ((m < 2) ? DFF : (m == 2) ? 6144 : (m == 3) ? DM : 4352);
            float mx = 0.f;
            for (int i = tid; i < n16 / 4; i += NTHR) { const f32x4 v = ((const f32x4*)W)[i]; mx = fmaxf(mx, fmaxf(fmaxf(fabsf(v[0]), fabsf(v[1])), fmaxf(fabsf(v[2]), fabsf(v[3])))); }
            mx = wave_max(mx);
            LAS float* red = (LAS float*)(lds + 2048);
            __syncthreads();
            if (lane == 0) red[wave] = mx;
            __syncthreads();
            if (tid == 0) { float t = 0.f; for (int w = 0; w < NWAVES; ++w) t = fmaxf(t, red[w]); const float R = fmaxf(1.25f * t, 1e-20f);
                ctl[CW_WSC + 2 * m] = __builtin_bit_cast(unsigned, 127.0f / R); ctl[CW_WSC + 2 * m + 1] = __builtin_bit_cast(unsigned, R * (1.0f / 127.0f)); }
        }
    }
    SEAM(-1);

    if (IN(0)) { const int tid = fresh_tid(), lane = tid & 63; (void)tid; (void)lane;
        LAS float* scr = (LAS float*)(lds + wave * 16384);
        constexpr int IT_AIN = (DM / 64) * (4352 / 32), IT_SQ = (DM / 64) * (DM / 32), IT_FGU = (DM / 64) * (DFF / 32), IT_FD = (DFF / 64) * (DM / 32);
        constexpr int IT_PPJ = (256 / 64) * (DM / 32), IT_HI = (DM / 64) * (6144 / 32), IT_EGU = (DM / 64) * (DFFE / 32), IT_ED = (DFFE / 64) * (DM / 32);
        constexpr int NIT = IT_FD + 2 * IT_PPJ + IT_SQ;
        for (int it = gw; it < NIT; it += NGW) {
            int r = it;
            if (r < IT_FD) { cvt_job(args.in[I_W_FD], DFF, DM, W_FD, 0, r, scr, lane); continue; } r -= IT_FD;
            if (r < 2 * IT_PPJ) { const int l = r / IT_PPJ; cvt_job(args.in[I_W_PP] + (size_t)l * 256 * DM, 256, DM, W_PP + (size_t)l * DM * 256, 0, r % IT_PPJ, scr, lane); continue; } r -= 2 * IT_PPJ;
            cvt_job(args.in[I_W_HO], DM, DM, W_HO, 0, r, scr, lane);
        }
        __syncthreads();
        {
            LAS float* scr8 = (LAS float*)(lds + wave * 16896);
            constexpr int IT8_EGU = (DM / 128) * (DFFE / 32), IT8_ED = (DFFE / 128) * (DM / 32);
            unsigned char* W8GU = (unsigned char*)W_EGU; unsigned char* W8D = (unsigned char*)W_ED;
            constexpr int IT8_PG = (DM / 128) * (DM / 32), IT8_AIN = (DM / 128) * (4352 / 32), IT8_X = 16 * IT8_EGU + 8 * IT8_ED;
            constexpr int IT8_FGU = (DM / 128) * (DFF / 32), IT8_HI = (DM / 128) * (6144 / 32);
            for (int it = gw; it < IT8_X + 2 * IT8_PG + IT8_AIN + 2 * IT8_FGU + IT8_HI + IT8_PG; it += NGW) {
                int r = it;
                if (r >= IT8_X + 2 * IT8_PG + IT8_AIN) { r -= IT8_X + 2 * IT8_PG + IT8_AIN;
                    if (r < 2 * IT8_FGU) { const int up = r / IT8_FGU;
                        cvt_job_i8(args.in[up ? I_W_FU : I_W_FG], DM, DFF, (unsigned char*)W_GU, up ? 2 : 1, r % IT8_FGU, scr8, lane, __builtin_bit_cast(float, __builtin_amdgcn_readfirstlane(ctl[CW_WSC + 2 * up]))); continue; }
                    r -= 2 * IT8_FGU;
                    if (r < IT8_HI) { cvt_job_i8(args.in[I_W_HI], DM, 6144, (unsigned char*)W_HI, 0, r, scr8, lane, __builtin_bit_cast(float, __builtin_amdgcn_readfirstlane(ctl[CW_WSC + 4]))); continue; }
                    r -= IT8_HI;
                    cvt_job_i8(args.in[I_W_PG], DM, DM, (unsigned char*)W_PG, 0, r, scr8, lane, __builtin_bit_cast(float, __builtin_amdgcn_readfirstlane(ctl[CW_WSC + 6]))); continue; }
                if (r >= IT8_X) { r -= IT8_X;
                    if (r < IT8_PG) { cvt_job8(args.in[I_W_PG] + (size_t)DM * DM, DM, DM, (unsigned char*)(ws + WS_PG8), 0, r, scr8, lane); continue; } r -= IT8_PG;
                    if (r < IT8_PG) { cvt_job8(args.in[I_W_AOUT], DM, DM, (unsigned char*)W_AO, 0, r, scr8, lane); continue; } r -= IT8_PG;
                    { const int nblk = 4352 / 32, kb = r / nblk, n0 = 32 * (r % nblk); unsigned char* dst; int drow0;
                      if (n0 < 1024) { dst = (unsigned char*)W_QK; drow0 = n0; } else if (n0 < 1152) { dst = (unsigned char*)W_V; drow0 = n0 - 1024; }
                      else if (n0 < 1280) { dst = (unsigned char*)W_V; drow0 = n0 - 1152 + 128; } else if (n0 < 2304) { dst = (unsigned char*)W_QK; drow0 = n0 - 1280 + 1024; }
                      else if (n0 < 3328) { dst = (unsigned char*)W_QK; drow0 = n0 - 2304 + 2048; } else { dst = (unsigned char*)W_V; drow0 = n0 - 3328 + 256; }
                      cvt_item8<true>(args.in[I_W_AIN], DM, 4352, dst, 128 * kb, n0, drow0, scr8, lane, __builtin_bit_cast(float, __builtin_amdgcn_readfirstlane(ctl[CW_WSC + 8]))); }
                    continue; }
                if (r < 16 * IT8_EGU) { const int j = r / IT8_EGU, e = j >> 1, up = j & 1;
                    cvt_job8(args.in[up ? I_W_EU : I_W_EG] + (size_t)e * DM * DFFE, DM, DFFE, W8GU + (size_t)e * 2 * DFFE * DM, up ? 2 : 1, r % IT8_EGU, scr8, lane); continue; }
                r -= 16 * IT8_EGU;
                { const int e = r / IT8_ED; cvt_job8(args.in[I_W_ED] + (size_t)e * DFFE * DM, DFFE, DM, W8D + (size_t)e * DM * DFFE, 0, r % IT8_ED, scr8, lane); }
            }
            __syncthreads();
        }
        { const f32x4* ps = (const f32x4*)args.in[I_P]; u32x2* pd = (u32x2*)PB; const int n4 = 2 * NTOK * 256 / 4;
          for (int i = gw * 64 + lane; i < n4; i += NGW * 64) { const f32x4 v = ps[i]; u32x2 w; w.x = pk2(v[0], v[1]); w.y = pk2(v[2], v[3]); pd[i] = w; } }
        { const int h1off = NGW >= 512 ? NGW - 512 : 0;
          for (int it = gw - h1off; it < 512; it += NGW) if (it >= 0) hy_hidden1(it, lane, args.in[I_W_F1], args.in[I_B_F1], args.in[I_FREQ], (float*)(ws + WS_H1)); }
        for (int it = gw; it < 256; it += NGW) cvt_item(args.in[I_W_F3], 256, 8192, BF, 0, 32 * it, 32 * it, scr, lane);
        { const u32x4 z4 = (u32x4){0u, 0u, 0u, 0u};
          for (int i = gw * 64 + lane; i < 8192 * 24; i += NGW * 64) { const int row = i / 24, ch = i % 24; *(u32x4*)(BF + (size_t)row * 256 + 64 + 8 * ch) = z4; } }
        for (int m = gw; m < NTOK; m += NGW) rms_row_i8(x + (size_t)m * DM, args.in[I_LN_MIX], (unsigned char*)HN + (size_t)m * DM, (float*)(ws + WS_RSC) + m, lane);
    }
    SEAM(0);

    if (IN(1)) { const int tid = fresh_tid(), lane = tid & 63; (void)tid; (void)lane;
        for (int it = NGW - 1 - gw; it < 512; it += NGW) hy_hidden2(it, lane, args.in[I_W_F2], args.in[I_B_F2], args.in[I_FREQ], (const float*)(ws + WS_H1), AF);
        { pg8::Gemm g{HN, W_QK, NTOK, 3072, DM / 2, DM / 2}; pg8::StaticOrder S; S.init(NTOK, 3072, G, bid);
          pg8::EpiBf16T<2> E{QA, 1024, 1024, (size_t)NTOK * 1024, __builtin_bit_cast(float, __builtin_amdgcn_readfirstlane(ctl[CW_WSC + 9])), (const float*)(ws + WS_RSC)};
          pg8::gemm_phase(lds, g, S, E); }
        { pg8::Gemm g{HN, W_V, NTOK, 1280, DM / 2, DM / 2}; pg8::StaticOrder S; S.init(NTOK, 1280, G, (bid + 128) % G);
          pg8::EpiVT<2> E{ws};
          pg8::gemm_phase(lds, g, S, E); }
        const int Gs = G > 64 ? G - 32 : G, cs = G > 64 ? bid - 32 : bid;
        if (cs >= 0)
#pragma unroll 1
        for (int l = 0; l < 2; ++l) {
          pg8::Gemm g{PB + (size_t)l * NTOK * 256, W_PP + (size_t)l * DM * 256, NTOK, DM, 256, 256}; pg8::StaticOrder S; S.init(NTOK, DM, Gs, cs);
          pg8::EpiBf16 E{PP + (size_t)l * NTOK * DM, DM, 0, 0, 1.0f, nullptr};
          pg8::gemm_phase(lds, g, S, E); }
    }
    SEAM(1);

    if (IN(2)) { const int tid = fresh_tid(), lane = tid & 63; (void)tid; (void)lane;
        { pg8::Gemm g{AF, BF, 4096, 8192, 256, 256}; pg8::StaticOrder S; S.init(4096, 8192, G, bid);
          pg8::EpiFilt E{FILT};
          pg8::gemm_phase(lds, g, S, E); }
        for (int u = bid; u < 256; u += G) attn_a_unit(u, tid, wave, lane, lds, QA, KA, VAT, AO, args.in[I_T5], args.in[I_SINK]);
        for (int u = bid; u < 1024; u += G) attn_b_unit(u, tid, wave, lane, lds, QN, KN, VNT, AO, args.in[I_RPB]);
    }
    SEAM(2);

    if (IN(3)) { const int tid = fresh_tid(), lane = tid & 63; (void)tid; (void)lane;
        pg8::Gemm g{AO, W_AO, NTOK, DM, DM / 2, DM / 2}; pg8::StaticOrder S; S.init(NTOK, DM, G, bid);
        pg8::EpiResidT<true> E{x, H, DM, 1.0f / 64.0f};
        pg8::gemm_phase(lds, g, S, E);
    }
    SEAM(3);

    if (IN(4)) { const int tid = fresh_tid(), lane = tid & 63; (void)tid; (void)lane; for (int m = gw; m < NTOK; m += NGW) rms_row_i8(H + (size_t)m * DM, args.in[I_LN_FFN], (unsigned char*)HN + (size_t)m * DM, (float*)(ws + WS_RSC) + m, lane); }
    SEAM(4);

    if (IN(5)) { const int tid = fresh_tid(), lane = tid & 63; (void)tid; (void)lane;
        pg8::Gemm g{HN, W_GU, NTOK, 2 * DFF, DM / 2, DM / 2}; pg8::StaticOrder S; S.init(NTOK, 2 * DFF, G, bid);
        pg8::EpiSwiGLUi8 E{MID, DFF, (const float*)(ws + WS_RSC), __builtin_bit_cast(float, __builtin_amdgcn_readfirstlane(ctl[CW_WSC + 1])), __builtin_bit_cast(float, __builtin_amdgcn_readfirstlane(ctl[CW_WSC + 3]))};
        pg8::gemm_phase(lds, g, S, E);
    }
    SEAM(5);

    if (IN(6)) { const int tid = fresh_tid(), lane = tid & 63; (void)tid; (void)lane;
        pg8::Gemm g{MID, W_FD, NTOK, DM, DFF, DFF}; pg8::StaticOrder S; S.init(NTOK, DM, G, bid);
        pg8::EpiResid E{H, H, DM, 1.0f};
        pg8::gemm_phase(lds, g, S, E);
    }
    SEAM(6);

    if (IN(7)) { const int tid = fresh_tid(), lane = tid & 63; (void)tid; (void)lane; for (int m = gw; m < NTOK; m += NGW) rms_row_i8(H + (size_t)m * DM, args.in[I_LN_PLE], (unsigned char*)HN + (size_t)m * DM, (float*)(ws + WS_RSC) + m, lane); }
    SEAM(7);

    if (IN(8)) { const int tid = fresh_tid(), lane = tid & 63; (void)tid; (void)lane;
        pg8::Gemm g{HN, W_PG, NTOK, DM, DM / 2, DM / 2}; pg8::StaticOrder S; S.init(NTOK, DM, G, bid);
        pg8::EpiPleT<2> E{H, PP, DM, __builtin_bit_cast(float, __builtin_amdgcn_readfirstlane(ctl[CW_WSC + 7])), (const float*)(ws + WS_RSC)};
        pg8::gemm_phase(lds, g, S, E);
    }
    SEAM(8);

    if (IN(9)) { const int tid = fresh_tid(), lane = tid & 63; (void)tid; (void)lane; for (int m = gw; m < NTOK; m += NGW) rms_row_i8(H + (size_t)m * DM, args.in[I_LN_MIX] + DM, (unsigned char*)HN + (size_t)m * DM, (float*)(ws + WS_RSC) + m, lane); }
    SEAM(9);

    if (IN(10)) { const int tid = fresh_tid(), lane = tid & 63; (void)tid; (void)lane;
        pg8::Gemm g{HN, W_HI, NTOK, 6144, DM / 2, DM / 2}; pg8::StaticOrder S; S.init(NTOK, 6144, G, bid);
        pg8::EpiProjTT<2> E{PROJT, args.in[I_B_HI], NTOK, __builtin_bit_cast(float, __builtin_amdgcn_readfirstlane(ctl[CW_WSC + 5])), (const float*)(ws + WS_RSC)};
        pg8::gemm_phase(lds, g, S, E);
    }
    SEAM(10);

    if (IN(11)) { const int tid = fresh_tid(), lane = tid & 63; (void)tid; (void)lane;
        for (int u = bid; u < 512; u += G) hyena_conv_unit(u, wave, lane, lds, PROJT, FILT, args.in[I_W_HC], args.in[I_B_HC], args.in[I_HYB], ZFT);
    }
    SEAM(11);

    if (IN(12)) { const int tid = fresh_tid(), lane = tid & 63; (void)tid; (void)lane; LAS unsigned short* tl = (LAS unsigned short*)(lds + wave * 16384); for (int t = gw; t < 32 * 128; t += NGW) transpose_tile(t, lane, tl, ZFT, ZF); }
    SEAM(12);

    if (IN(13)) { const int tid = fresh_tid(), lane = tid & 63; (void)tid; (void)lane;
        pg8::Gemm g{ZF, W_HO, NTOK, DM, DM, DM}; pg8::StaticOrder S; S.init(NTOK, DM, G, bid);
        pg8::EpiResid E{H, H, DM, 1.0f};
        pg8::gemm_phase(lds, g, S, E);
    }
    SEAM(13);

    if (IN(14)) { const int tid = fresh_tid(), lane = tid & 63; (void)tid; (void)lane;
        LAS unsigned* lhist = (LAS unsigned*)(lds + 1024);
        for (int tb = bid; tb < 256; tb += G) {
            if (tid < 8) lhist[tid] = 0u;
            __syncthreads();
            for (int i = 0; i < 4; ++i) router_token(tb * 32 + wave * 4 + i, lane, H, args.in[I_LN_FFN] + DM, args.in[I_W_RT], HN, ctl, lhist);
            __syncthreads();
            if (tid < 8) ctl[CW_HIST + tb * 8 + tid] = lhist[tid];
            __syncthreads();
        }
    }
    SEAM(14);

    if (IN(15)) { const int tid = fresh_tid(), lane = tid & 63; (void)tid; (void)lane;
        LAS unsigned* lw = (LAS unsigned*)(lds + 1024);
        for (int tb = bid; tb < 256; tb += G) {
            { const int e = tid & 7, q = tid >> 3;
              unsigned tot = 0u, bef = 0u;
#pragma unroll
              for (int i = 0; i < 4; ++i) { const int t2 = 4 * q + i; const unsigned h = ctl[CW_HIST + t2 * 8 + e]; tot += h; bef += (t2 < tb) ? h : 0u; }
#pragma unroll
              for (int o = 8; o < 64; o <<= 1) { tot += __shfl_xor(tot, o); bef += __shfl_xor(bef, o); }
              if (lane < 8) { lw[32 + wave * 16 + lane] = tot; lw[32 + wave * 16 + 8 + lane] = bef; } }
            __syncthreads();
            if (tid < 8) { unsigned tot = 0u, bef = 0u;
#pragma unroll
                for (int w = 0; w < 8; ++w) { tot += lw[32 + w * 16 + tid]; bef += lw[32 + w * 16 + 8 + tid]; }
                lw[tid] = bef; lw[16 + tid] = tot; }
            __syncthreads();
            if (tid == 0) { unsigned st = 0u; int nt = 0;
                for (int e = 0; e < 8; ++e) { lw[8 + e] = st; const unsigned tiles = (lw[16 + e] + 255u) >> 8;
                    if (tb == 0) for (unsigned q = 0; q < tiles; ++q) ctl[CW_TILEEXP + nt + (int)q] = (unsigned)e;
                    nt += (int)tiles; st += tiles << 8; }
                if (tb == 0) ctl[CW_TILEEXP + MAXTILES] = (unsigned)nt; }
            __syncthreads();
            if (wave == 0) { const int tok = tb * 32 + (lane >> 1), k = lane & 1; const unsigned e = ctl[CW_TOKE + 2 * tok + k];
                unsigned rank = 0u;
#pragma unroll
                for (unsigned q = 0; q < 8; ++q) { const unsigned long long mk = __ballot(e == q); if (e == q) rank = (unsigned)__popcll(mk & ((1ull << lane) - 1ull)); }
                const unsigned slot = lw[8 + e] + lw[e] + rank;
                ctl[CW_TOKS + 2 * tok + k] = slot; lw[192 + lane] = slot; }
            __syncthreads();
            for (int q = 0; q < 8; ++q) { const int ent = wave * 8 + q; const int tok = tb * 32 + (ent >> 1); const unsigned slot = lw[192 + ent];
                const u32x4* src = (const u32x4*)((const unsigned char*)HN + (size_t)tok * DM) + lane; u32x4* dst = (u32x4*)((unsigned char*)XS + (size_t)slot * DM) + lane;
#pragma unroll
                for (int i = 0; i < 2; ++i) dst[64 * i] = src[64 * i]; }
            __syncthreads();
        }
    }
    SEAM(15);

    if (IN(16)) { const int tid = fresh_tid(), lane = tid & 63; (void)tid; (void)lane;
        const int ntl = (int)__builtin_amdgcn_readfirstlane(ctl[CW_TILEEXP + MAXTILES]);
        pg8::Gemm g{XS, W_EGU, ntl * 256, 2 * DFFE, DM / 2, DM / 2}; pg8::GroupedOrder S; S.init(ntl * 256, 2 * DFFE, G, bid); S.tile_exp = (const int*)(ctl + CW_TILEEXP); S.estride = (size_t)2 * DFFE * DM / 2;
        if (bid == 0) { pg8::StaticOrder T; T.init(ntl * 256, DM, 1, 0); const int nun = ntl * 8, full = (nun / G) * G, tail = nun - full;
            int Sp = 1;
            if (14 * tail <= G) Sp = 14; else if (7 * tail <= G) Sp = 7; else if (4 * tail <= G) Sp = 4; else if (2 * tail <= G) Sp = 2;
            if (tid < tail) { pg8::Unit tu; T.unit_at(full + tid, tu); ctl[CW_TAILMAP + tu.pm * 8 + tu.pn] = 1u + (unsigned)tid; }
            if (tid == 0) ctl[CW_TAILSP] = (unsigned)Sp; }
        pg8::EpiSwiGLU8 E{(unsigned char*)HMID, DFFE};
        pg8::gemm_phase(lds, g, S, E);
    }
    SEAM(16);

    if (IN(17)) { const int tid = fresh_tid(), lane = tid & 63; (void)tid; (void)lane;
        const int ntl = (int)__builtin_amdgcn_readfirstlane(ctl[CW_TILEEXP + MAXTILES]);
        pg8::Gemm g{HMID, W_ED, ntl * 256, DM, DFFE / 2, DFFE / 2}; pg8::GroupedOrder S; S.init(ntl * 256, DM, G, bid); S.tile_exp = (const int*)(ctl + CW_TILEEXP); S.estride = (size_t)DM * DFFE / 2;
        const int nun = ntl * 8, full = (nun / G) * G, tail = nun - full;
        S.limit = full;
        pg8::EpiF32s8 E{Y, DM, 1.0f / 64.0f};
        pg8::gemm_phase(lds, g, S, E);
        if (tail > 0) {
            const int Sp = (int)__builtin_amdgcn_readfirstlane(ctl[CW_TAILSP]);
            pg8::TailOrder T; T.init(ntl * 256, DM, G, bid); T.tile_exp = S.tile_exp; T.estride = S.estride; T.first = full; T.ntail = tail; T.S = Sp; T.kslice = DFFE / 2 / Sp;
            pg8::Gemm g2{HMID, W_ED, ntl * 256, DM, DFFE / 2 / Sp, DFFE / 2};
            pg8::EpiPartTile8 E2{(float*)(ws + WS_XS), 1.0f / 64.0f};
            pg8::gemm_phase(lds, g2, T, E2);
        }
    }
    SEAM(17);

    if (IN(18)) { const int tid = fresh_tid(), lane = tid & 63; (void)tid; (void)lane;
        for (int m = gw; m < NTOK; m += NGW) {
            const unsigned s0 = ctl[CW_TOKS + 2 * m], s1 = ctl[CW_TOKS + 2 * m + 1];
            const float g0 = __builtin_bit_cast(float, ctl[CW_TOKG + 2 * m]), g1 = __builtin_bit_cast(float, ctl[CW_TOKG + 2 * m + 1]);
            f32x4* hr = (f32x4*)(H + (size_t)m * DM) + lane; const f32x4* y0 = (const f32x4*)(Y + (size_t)s0 * DM) + lane; const f32x4* y1 = (const f32x4*)(Y + (size_t)s1 * DM) + lane;
            const float* YP = (const float*)(ws + WS_XS); const int Sp = (int)ctl[CW_TAILSP];
            f32x4 v[8]; float ss = 0.f;
#pragma unroll
            for (int j = 0; j < 8; ++j) {
                f32x4 a0, a1;
                const unsigned t0 = ctl[CW_TAILMAP + (s0 >> 8) * 8 + j], t1 = ctl[CW_TAILMAP + (s1 >> 8) * 8 + j];
                if (t0 == 0u) a0 = y0[64 * j]; else { a0 = (f32x4){0.f, 0.f, 0.f, 0.f}; const f32x4* pp = (const f32x4*)(YP + (size_t)((t0 - 1u) * Sp) * 65536 + (size_t)(s0 & 255u) * 256) + lane; for (int q = 0; q < Sp; ++q) a0 += pp[(size_t)q * 16384]; }
                if (t1 == 0u) a1 = y1[64 * j]; else { a1 = (f32x4){0.f, 0.f, 0.f, 0.f}; const f32x4* pp = (const f32x4*)(YP + (size_t)((t1 - 1u) * Sp) * 65536 + (size_t)(s1 & 255u) * 256) + lane; for (int q = 0; q < Sp; ++q) a1 += pp[(size_t)q * 16384]; }
                v[j] = hr[64 * j] + (a0 * g0 + a1 * g1); hr[64 * j] = v[j]; ss += (v[j][0] * v[j][0] + v[j][1] * v[j][1]) + (v[j][2] * v[j][2] + v[j][3] * v[j][3]); }
            const float rstd = 1.0f / sqrtf(wave_sum(ss) * (1.f / DM) + RMS_EPS);
            const f32x4* gr = (const f32x4*)(args.in[I_LN_PLE] + DM) + lane; unsigned* o8 = (unsigned*)((unsigned char*)HN + (size_t)m * DM) + lane;
#pragma unroll
            for (int j = 0; j < 8; ++j) { const f32x4 g = gr[64 * j]; o8[64 * j] = pk4_fp8(v[j][0] * rstd * g[0], v[j][1] * rstd * g[1], v[j][2] * rstd * g[2], v[j][3] * rstd * g[3]); }
        }
    }
    SEAM(18);

    if (IN(19)) { const int tid = fresh_tid(), lane = tid & 63; (void)tid; (void)lane;
        pg8::Gemm g{HN, (const bf16*)(ws + WS_PG8), NTOK, DM, DM / 2, DM / 2}; pg8::StaticOrder S; S.init(NTOK, DM, G, bid);
        pg8::EpiPle8 E{H, PP + (size_t)NTOK * DM, DM};
        pg8::gemm_phase(lds, g, S, E);
    }
    SEAM(19);

    if (LAST_PHASE < 19 && lo <= 19 && 20 < hi) GRID_BAR();
    if (IN(20)) { const int tid = fresh_tid(), lane = tid & 63; (void)tid; (void)lane;
        const float* src = (LAST_PHASE < 3) ? x : H;
        for (int m = gw; m < NTOK; m += NGW) rms_row_f32(src + (size_t)m * DM, args.in[I_FINAL], args.out + (size_t)m * DM, lane);
    }
#undef IN
#undef SEAM
}

extern "C" void kernel_launch(void* const* d_in, const int* in_sizes, int n_in, void* d_out, int out_size, void* d_ws, size_t ws_size, hipStream_t stream) {
    static int grid = 0;
    if (grid == 0) {
        if (n_in != 32 || out_size != NTOK * DM || ws_size < WS_END) { fprintf(stderr, "kernel_launch: unexpected shapes: n_in %d out %d ws %zu (need %zu)\n", n_in, out_size, ws_size, (size_t)WS_END); grid = -1; return; }
        int dev = 0, cus = 0, per_cu = 0;
        if (hipGetDevice(&dev) != hipSuccess || hipDeviceGetAttribute(&cus, hipDeviceAttributeMultiprocessorCount, dev) != hipSuccess) { grid = -1; return; }
        if (hipFuncSetAttribute((const void*)fwd_kernel, hipFuncAttributeMaxDynamicSharedMemorySize, LDS_BYTES) != hipSuccess) { fprintf(stderr, "kernel_launch: hipFuncSetAttribute failed\n"); grid = -1; return; }
        if (hipOccupancyMaxActiveBlocksPerMultiprocessor(&per_cu, (const void*)fwd_kernel, NTHR, LDS_BYTES) != hipSuccess || per_cu < 1) fprintf(stderr, "kernel_launch: occupancy query reports %d\n", per_cu);
        (void)hipGetLastError();
        grid = cus;
    }
    if (grid < 0) return;
    if (hipMemsetAsync((char*)d_ws + WS_CTL, 0, CTL_BYTES, stream) != hipSuccess) return;
    Args a{};
    for (int i = 0; i < 32; ++i) a.in[i] = (const float*)d_in[i];
    a.out = (float*)d_out; a.ws = (unsigned char*)d_ws;
#if MK_ONE_LAUNCH
    a.ph_lo = -1; a.ph_hi = 64;
    hipLaunchKernelGGL(fwd_kernel, dim3(grid), dim3(NTHR), LDS_BYTES, stream, a);
#else
    for (int ph = -1; ph <= 20; ++ph) {
        if (ph > LAST_PHASE && ph != 20) continue;

        a.ph_lo = ph; a.ph_hi = ph + 1;
        hipLaunchKernelGGL(fwd_kernel, dim3(grid), dim3(NTHR), LDS_BYTES, stream, a);
    }
#endif
}
```
